# Optimizing an MI355X kernel written in HIP

```python
import jax, jax.numpy as jnp
from jax import lax
import numpy as np

D_MODEL = 1024
BATCH = 8
SEQ = 2048
DEPTH = 1
DEC_BATCH = 128
DEC_SEQ = 8
PAST_LEN = 16384
PAGE_SIZE = 128

D_MIX = D_MODEL
LRU_WIDTH = D_MIX // 2
LRU_HEADS = 8
LRU_HEAD_DIM = LRU_WIDTH // LRU_HEADS
LRU_C = 8.0
CONV_W = 4
POOL_WIDTH = D_MIX - LRU_WIDTH
POOL_WINDOWS = (2, 4, 8, 16)
POOL_GROUPS = len(POOL_WINDOWS)
POOL_GROUP_DIM = POOL_WIDTH // POOL_GROUPS
POOL_MAX = max(POOL_WINDOWS)
D_FF = 2816
MEM_LEN = 256
XA_HEADS = 4
XA_HEAD_DIM = D_MODEL // XA_HEADS
EPS = 1e-6

kernel_name = "hymba_rglru_pool_macaron_memxattn_step"


def rmsnorm(x, g):
    xf = x.astype(jnp.float32)
    var = jnp.mean(xf * xf, axis=-1, keepdims=True)
    return (xf * lax.rsqrt(var + EPS) * g.astype(jnp.float32)).astype(x.dtype)


def swiglu(x, w_gate, w_up, w_down):
    return (jax.nn.silu(x @ w_gate) * (x @ w_up)) @ w_down


def block_diag(u, w):
    b, t, _ = u.shape
    g, dg, _ = w.shape
    uh = u.reshape(b, t, g, dg)
    return jnp.einsum('btgi,gij->btgj', uh, w).reshape(b, t, g * dg)


def causal_conv(u, buf, w, bias):
    t = u.shape[1]
    ext = jnp.concatenate([buf, u], axis=1)
    out = bias + sum(ext[:, k:k + t] * w[k] for k in range(CONV_W))
    return out, ext[:, -(CONV_W - 1):]


def rglru(u, h0, wa, ba, wx, bx, lam):
    r = jax.nn.sigmoid(block_diag(u, wa) + ba).astype(jnp.float32)
    i = jax.nn.sigmoid(block_diag(u, wx) + bx).astype(jnp.float32)
    log_a = -LRU_C * r * jax.nn.softplus(-lam.astype(jnp.float32))
    a = jnp.exp(log_a)
    mult = jnp.sqrt(jnp.maximum(-jnp.expm1(2.0 * log_a), 0.0))
    bterm = mult * i * u.astype(jnp.float32)

    def step(h, ab):
        a_t, b_t = ab
        h = a_t * h + b_t
        return h, h

    h_last, hs = lax.scan(step, h0.astype(jnp.float32),
                          (jnp.swapaxes(a, 0, 1), jnp.swapaxes(bterm, 0, 1)))
    return jnp.swapaxes(hs, 0, 1).astype(u.dtype), h_last.astype(h0.dtype)


def pool_mixer(u, buf, pos0, w, scale):
    b, t, c = u.shape
    ext = jnp.concatenate([buf, u], axis=1)
    cs = jnp.cumsum(ext.astype(jnp.float32), axis=1)
    cs = jnp.pad(cs, ((0, 0), (1, 0), (0, 0)))
    csg = cs.reshape(b, t + POOL_MAX, POOL_GROUPS, POOL_GROUP_DIM)
    pos = pos0 + jnp.arange(t)
    pooled = []
    for g, win in enumerate(POOL_WINDOWS):
        s = csg[:, POOL_MAX:POOL_MAX + t, g] - csg[:, POOL_MAX - win:POOL_MAX - win + t, g]
        cnt = jnp.minimum(pos + 1, win).astype(jnp.float32)
        pooled.append(s / cnt[None, :, None])
    pooled = jnp.stack(pooled, axis=2).reshape(b, t, c)
    delta = (pooled - u.astype(jnp.float32)).astype(u.dtype)
    out = scale * block_diag(delta, w)
    return out, ext[:, -(POOL_MAX - 1):]


def mem_kv(mem, g, wk, wv):
    m = rmsnorm(mem, g)
    b = mem.shape[0]
    k = (m @ wk).reshape(b, MEM_LEN, XA_HEADS, XA_HEAD_DIM)
    v = (m @ wv).reshape(b, MEM_LEN, XA_HEADS, XA_HEAD_DIM)
    return k, v


def cross_attend(h, k, v, wq, wo):
    b, t, _ = h.shape
    q = (h @ wq).reshape(b, t, XA_HEADS, XA_HEAD_DIM)
    s = jnp.einsum('bthd,bmhd->bhtm', q, k).astype(jnp.float32) * (XA_HEAD_DIM ** -0.5)
    p = jax.nn.softmax(s, axis=-1).astype(v.dtype)
    o = jnp.einsum('bhtm,bmhd->bthd', p, v).reshape(b, t, D_MODEL)
    return o @ wo


def layer_forward(x, conv_buf, lru_h, pool_buf, mem_k, mem_v, pos0, p):
    x = x + 0.5 * swiglu(rmsnorm(x, p['ffn1_norm']), p['ffn1_w_gate'], p['ffn1_w_up'], p['ffn1_w_down'])
    h = rmsnorm(x, p['mix_norm'])
    proj = h @ p['w_in']
    u_lru, gate, u_pool = jnp.split(proj, [LRU_WIDTH, 2 * LRU_WIDTH], axis=-1)
    u_conv, conv_buf = causal_conv(u_lru, conv_buf, p['conv_w'], p['conv_b'])
    hs, lru_h = rglru(u_conv, lru_h, p['lru_wa'], p['lru_ba'], p['lru_wx'], p['lru_bx'], p['lru_lambda'])
    y_lru = jax.nn.gelu(gate) * hs
    y_pool, pool_buf = pool_mixer(u_pool, pool_buf, pos0, p['pool_w'], p['pool_scale'])
    x = x + jnp.concatenate([y_lru, y_pool], axis=-1) @ p['w_out']
    x = x + cross_attend(rmsnorm(x, p['xattn_norm']), mem_k, mem_v, p['xattn_wq'], p['xattn_wo'])
    x = x + 0.5 * swiglu(rmsnorm(x, p['ffn2_norm']), p['ffn2_w_gate'], p['ffn2_w_up'], p['ffn2_w_down'])
    return x, conv_buf, lru_h, pool_buf


def setup_inputs(seed: int = 0) -> dict:
    key = jax.random.key(seed)
    ks = iter(jax.random.split(key, 48))

    def nrm(shape, scale=1.0):
        return jax.random.normal(next(ks), shape, jnp.float32) * scale

    def gain(n=D_MODEL):
        return 1.0 + nrm((DEPTH, n), 0.02)

    d = D_MODEL
    a8 = jax.random.uniform(next(ks), (DEPTH, LRU_WIDTH), jnp.float32, 0.9, 0.999)
    pa = a8 ** (1.0 / LRU_C)
    lru_lambda = jnp.log(pa) - jnp.log1p(-pa)
    return {
        'x_prompt': nrm((BATCH, SEQ, d)),
        'x_sample': nrm((DEC_BATCH, DEC_SEQ, d)),
        'mem_prompt': nrm((BATCH, MEM_LEN, d)),
        'state_conv': nrm((DEPTH, DEC_BATCH, CONV_W - 1, LRU_WIDTH)),
        'state_lru': nrm((DEPTH, DEC_BATCH, LRU_WIDTH), 0.5),
        'state_pool': nrm((DEPTH, DEC_BATCH, POOL_MAX - 1, POOL_WIDTH)),
        'cache_mem_k': nrm((DEPTH, DEC_BATCH, MEM_LEN, XA_HEADS, XA_HEAD_DIM)),
        'cache_mem_v': nrm((DEPTH, DEC_BATCH, MEM_LEN, XA_HEADS, XA_HEAD_DIM)),
        'ffn1_norm': gain(),
        'ffn1_w_gate': nrm((DEPTH, d, D_FF), d ** -0.5),
        'ffn1_w_up': nrm((DEPTH, d, D_FF), d ** -0.5),
        'ffn1_w_down': nrm((DEPTH, D_FF, d), D_FF ** -0.5),
        'mix_norm': gain(),
        'w_in': nrm((DEPTH, d, 2 * LRU_WIDTH + POOL_WIDTH), d ** -0.5),
        'conv_w': nrm((DEPTH, CONV_W, LRU_WIDTH), CONV_W ** -0.5),
        'conv_b': nrm((DEPTH, LRU_WIDTH), 0.01),
        'lru_wa': nrm((DEPTH, LRU_HEADS, LRU_HEAD_DIM, LRU_HEAD_DIM), LRU_HEAD_DIM ** -0.5),
        'lru_ba': nrm((DEPTH, LRU_WIDTH), 0.01),
        'lru_wx': nrm((DEPTH, LRU_HEADS, LRU_HEAD_DIM, LRU_HEAD_DIM), LRU_HEAD_DIM ** -0.5),
        'lru_bx': nrm((DEPTH, LRU_WIDTH), 0.01),
        'lru_lambda': lru_lambda,
        'pool_w': nrm((DEPTH, POOL_GROUPS, POOL_GROUP_DIM, POOL_GROUP_DIM), POOL_GROUP_DIM ** -0.5),
        'pool_scale': gain(POOL_WIDTH),
        'w_out': nrm((DEPTH, D_MIX, d), D_MIX ** -0.5),
        'xattn_norm': gain(),
        'mem_norm': gain(),
        'xattn_wq': nrm((DEPTH, d, d), d ** -0.5),
        'xattn_wk': nrm((DEPTH, d, d), d ** -0.5),
        'xattn_wv': nrm((DEPTH, d, d), d ** -0.5),
        'xattn_wo': nrm((DEPTH, d, d), d ** -0.5),
        'ffn2_norm': gain(),
        'ffn2_w_gate': nrm((DEPTH, d, D_FF), d ** -0.5),
        'ffn2_w_up': nrm((DEPTH, d, D_FF), d ** -0.5),
        'ffn2_w_down': nrm((DEPTH, D_FF, d), D_FF ** -0.5),
        'final_norm': 1.0 + nrm((D_MODEL,), 0.02),
    }


def reference(x_prompt, x_sample, mem_prompt, state_conv, state_lru, state_pool, cache_mem_k, cache_mem_v,
              ffn1_norm, ffn1_w_gate, ffn1_w_up, ffn1_w_down,
              mix_norm, w_in, conv_w, conv_b, lru_wa, lru_ba, lru_wx, lru_bx, lru_lambda, pool_w, pool_scale, w_out,
              xattn_norm, mem_norm, xattn_wq, xattn_wk, xattn_wv, xattn_wo,
              ffn2_norm, ffn2_w_gate, ffn2_w_up, ffn2_w_down,
              final_norm):
    yp, ys = x_prompt, x_sample
    b = x_prompt.shape[0]
    zero_conv = jnp.zeros((b, CONV_W - 1, LRU_WIDTH), x_prompt.dtype)
    zero_h = jnp.zeros((b, LRU_WIDTH), state_lru.dtype)
    zero_pool = jnp.zeros((b, POOL_MAX - 1, POOL_WIDTH), x_prompt.dtype)
    p_conv, p_lru, p_pool, p_mk, p_mv = [], [], [], [], []
    s_conv, s_lru, s_pool = [], [], []
    for l in range(DEPTH):
        prm = {
            'ffn1_norm': ffn1_norm[l], 'ffn1_w_gate': ffn1_w_gate[l], 'ffn1_w_up': ffn1_w_up[l],
            'ffn1_w_down': ffn1_w_down[l], 'mix_norm': mix_norm[l], 'w_in': w_in[l],
            'conv_w': conv_w[l], 'conv_b': conv_b[l], 'lru_wa': lru_wa[l], 'lru_ba': lru_ba[l],
            'lru_wx': lru_wx[l], 'lru_bx': lru_bx[l], 'lru_lambda': lru_lambda[l],
            'pool_w': pool_w[l], 'pool_scale': pool_scale[l], 'w_out': w_out[l],
            'xattn_norm': xattn_norm[l], 'xattn_wq': xattn_wq[l], 'xattn_wo': xattn_wo[l],
            'ffn2_norm': ffn2_norm[l], 'ffn2_w_gate': ffn2_w_gate[l], 'ffn2_w_up': ffn2_w_up[l],
            'ffn2_w_down': ffn2_w_down[l],
        }
        mk, mv = mem_kv(mem_prompt, mem_norm[l], xattn_wk[l], xattn_wv[l])
        yp, pc, ph, pb = layer_forward(yp, zero_conv, zero_h, zero_pool, mk, mv, 0, prm)
        p_conv.append(pc); p_lru.append(ph); p_pool.append(pb); p_mk.append(mk); p_mv.append(mv)
        ys, sc, sh, sb = layer_forward(ys, state_conv[l], state_lru[l], state_pool[l],
                                       cache_mem_k[l], cache_mem_v[l], PAST_LEN, prm)
        s_conv.append(sc); s_lru.append(sh); s_pool.append(sb)
    y_prompt = rmsnorm(yp, final_norm)
    y_sample = rmsnorm(ys, final_norm)
    return (y_prompt, y_sample,
            jnp.stack(p_conv), jnp.stack(p_lru), jnp.stack(p_pool), jnp.stack(p_mk), jnp.stack(p_mv),
            jnp.stack(s_conv), jnp.stack(s_lru), jnp.stack(s_pool))
```

```cpp
#include <hip/hip_runtime.h>
#include <hip/hip_cooperative_groups.h>
#include <cstdio>
#include <cstdint>
namespace cg = cooperative_groups;
namespace pg8 {
#define PG8_LAS __attribute__((address_space(3)))
typedef unsigned short bf16_t;
typedef short bf16x8 __attribute__((ext_vector_type(8)));
typedef float f32x4 __attribute__((ext_vector_type(4)));
typedef unsigned u32x4 __attribute__((ext_vector_type(4)));
constexpr int BM = 256, BK = 64, HALF = 128, HTB = HALF * BK * 2  , STAGE_BYTES = 8 * HTB, NXCD = 8, WGM = 8;

__host__ __device__ __forceinline__ int lds_byte(int r, int c) { const int st = (r >> 4) * 2 + (c >> 5), rr = r & 15, cc = c & 31, ob = rr * 64 + cc * 2; return st * 1024 + (ob ^ (((ob >> 9) & 1) << 5)); }
__host__ __device__ __forceinline__ void stage_rc(int b, int& R, int& C) { const int st = b / 1024, sb = b % 1024, swz = sb ^ (((sb >> 9) & 1) << 5); R = (st >> 1) * 16 + swz / 64; C = (st & 1) * 32 + (swz % 64) / 2; }
__host__ __device__ __forceinline__ int perm32(int rho) { const int n = rho >> 4, i = rho & 15; return 8 * (i >> 2) + 4 * n + (i & 3); }

struct Unit { int pm, pn; };
struct Gemm { const bf16_t* A; const bf16_t* Bt; int M, N, K; };

struct StaticOrder {
    int nM, nN, nwg, G, c;
    __host__ __device__ void init(int M, int N, int G_, int c_) { nM = M / BM; nN = N / BM; nwg = nM * nN; G = G_; c = c_; }
    __host__ __device__ bool next(int i, Unit& u) const {
        const long L = (long)i * G + c; if (L >= nwg) return false;
        int wgid = (int)L; { const int q = nwg / NXCD, r = nwg % NXCD, xcd = wgid % NXCD, off = wgid / NXCD; wgid = (xcd < r ? xcd * (q + 1) : r * (q + 1) + (xcd - r) * q) + off; }
        const int nig = WGM * nN, gid = wgid / nig, fm = gid * WGM, gsz = (nM - fm) < WGM ? (nM - fm) : WGM;
        u.pm = fm + ((wgid % nig) % gsz); u.pn = (wgid % nig) / gsz; return true;
    }
    __device__ __forceinline__ void a_ready(const Unit&) const {}
    __device__ __forceinline__ void done(const Unit&) const {}
};

__device__ __forceinline__ unsigned cvt_pk_bf16(float lo, float hi) { unsigned r; asm volatile("v_cvt_pk_bf16_f32 %0, %1, %2" : "=v"(r) : "v"(lo), "v"(hi)); return r; }
typedef float f32x2 __attribute__((ext_vector_type(2)));
__device__ __forceinline__ f32x2 gelu_pk(f32x2 v) {
    const f32x2 av = __builtin_elementwise_abs(v), d = av * 0.2316418882f + 1.0f;
    f32x2 t; t.x = __builtin_amdgcn_rcpf(d.x); t.y = __builtin_amdgcn_rcpf(d.y);
    f32x2 q = t * 0.5307027145f + (-0.7265760135f); q = q * t + 0.7107068705f; q = q * t + (-0.142248368f); q = q * t + 0.127414796f; q = q * t;
    const f32x2 s = (v * v) * (-0.72134752044f);
    f32x2 e; e.x = __builtin_amdgcn_exp2f(s.x); e.y = __builtin_amdgcn_exp2f(s.y);
    const f32x2 m = v * (q * e), r = v - m;
    f32x2 o; o.x = v.x < 0.f ? m.x : r.x; o.y = v.y < 0.f ? m.y : r.y; return o;
}

constexpr int MP_ROWS = 16384;
__device__ __forceinline__ float rstd_of(float ss) { return rsqrtf(ss * (1.0f / 1024.0f) + 1e-6f); }
__device__ __forceinline__ float fsigmoid(float x) { return __builtin_amdgcn_rcpf(1.0f + __expf(-x)); }
struct EpiSwiGLU {
    static constexpr bool PERM = true, AFTER_DRAIN = false;
    bf16_t* H; const float* ss; int ldh;
    __device__ __forceinline__ void operator()(const f32x4 (&acc)[2][2][4][2], const Unit& u, int wr, int wc, int fr, int fq) const {
#pragma unroll
        for (int ai = 0; ai < 2; ++ai)
#pragma unroll
            for (int m = 0; m < 4; ++m) { const int row = u.pm * BM + ai * HALF + wr * 64 + m * 16 + fr; const float rs = rstd_of(ss[row]);
                float hv[8];
#pragma unroll
                for (int n = 0; n < 2; ++n)
#pragma unroll
                    for (int i = 0; i < 4; ++i) { const float g = acc[ai][0][m][n][i] * rs, uu = acc[ai][1][m][n][i] * rs; hv[n * 4 + i] = g * uu * fsigmoid(g); }
                u32x4 w; w.x = cvt_pk_bf16(hv[0], hv[1]); w.y = cvt_pk_bf16(hv[2], hv[3]); w.z = cvt_pk_bf16(hv[4], hv[5]); w.w = cvt_pk_bf16(hv[6], hv[7]);
                *(u32x4*)(H + (size_t)row * ldh + u.pn * HALF + wc * 32 + 8 * fq) = w; }
    }
};
struct EpiResid {
    static constexpr bool PERM = true, AFTER_DRAIN = false;
    const bf16_t* xin; float* xout; bf16_t* xb; float* ss; float alpha;
    __device__ __forceinline__ void operator()(const f32x4 (&acc)[2][2][4][2], const Unit& u, int wr, int wc, int fr, int fq) const {
#pragma unroll
        for (int ai = 0; ai < 2; ++ai)
#pragma unroll
            for (int m = 0; m < 4; ++m) { const int row = u.pm * BM + ai * HALF + wr * 64 + m * 16 + fr;
                float sq = 0.f;
#pragma unroll
                for (int bj = 0; bj < 2; ++bj) { const int col = u.pn * BM + bj * HALF + wc * 32 + 8 * fq;
                    const u32x4 xw = *(const u32x4*)(xin + (size_t)row * 1024 + col);
                    const f32x4 a0 = {__uint_as_float(xw.x << 16), __uint_as_float(xw.x & 0xffff0000u), __uint_as_float(xw.y << 16), __uint_as_float(xw.y & 0xffff0000u)};
                    const f32x4 a1 = {__uint_as_float(xw.z << 16), __uint_as_float(xw.z & 0xffff0000u), __uint_as_float(xw.w << 16), __uint_as_float(xw.w & 0xffff0000u)};
                    const f32x4 v0 = a0 + acc[ai][bj][m][0] * alpha, v1 = a1 + acc[ai][bj][m][1] * alpha;
                    if (xout) { *(f32x4*)(xout + (size_t)row * 1024 + col) = v0; *(f32x4*)(xout + (size_t)row * 1024 + col + 4) = v1; }
                    if (xb) { u32x4 w; w.x = cvt_pk_bf16(v0[0], v0[1]); w.y = cvt_pk_bf16(v0[2], v0[3]); w.z = cvt_pk_bf16(v1[0], v1[1]); w.w = cvt_pk_bf16(v1[2], v1[3]);
                        *(u32x4*)(xb + (size_t)row * 1024 + col) = w; }
                    sq += (v0[0] * v0[0] + v0[1] * v0[1]) + (v0[2] * v0[2] + v0[3] * v0[3]) + (v1[0] * v1[0] + v1[1] * v1[1]) + (v1[2] * v1[2] + v1[3] * v1[3]); }
                sq += __shfl_xor(sq, 16); sq += __shfl_xor(sq, 32);
                if (fq == 0) unsafeAtomicAdd(ss + row, sq); }
    }
};
struct EpiScaleBf16 {
    static constexpr bool PERM = true, AFTER_DRAIN = false;
    bf16_t* O; int ldc; const float* ss; float mul;
    __device__ __forceinline__ void operator()(const f32x4 (&acc)[2][2][4][2], const Unit& u, int wr, int wc, int fr, int fq) const {
#pragma unroll
        for (int ai = 0; ai < 2; ++ai)
#pragma unroll
            for (int m = 0; m < 4; ++m) { const int row = u.pm * BM + ai * HALF + wr * 64 + m * 16 + fr; const float rs = rstd_of(ss[row]) * mul;
#pragma unroll
                for (int bj = 0; bj < 2; ++bj) { const int col = u.pn * BM + bj * HALF + wc * 32 + 8 * fq;
                    const f32x4 v0 = acc[ai][bj][m][0] * rs, v1 = acc[ai][bj][m][1] * rs;
                    u32x4 w; w.x = cvt_pk_bf16(v0[0], v0[1]); w.y = cvt_pk_bf16(v0[2], v0[3]); w.z = cvt_pk_bf16(v1[0], v1[1]); w.w = cvt_pk_bf16(v1[2], v1[3]);
                    *(u32x4*)(O + (size_t)row * ldc + col) = w; } }
    }
};
struct EpiKV {
    static constexpr bool PERM = true, AFTER_DRAIN = false;
    float* outK; float* outV; bf16_t* KB; const float* ss;
    __device__ __forceinline__ void operator()(const f32x4 (&acc)[2][2][4][2], const Unit& u, int wr, int wc, int fr, int fq) const {
#pragma unroll
        for (int ai = 0; ai < 2; ++ai)
#pragma unroll
            for (int m = 0; m < 4; ++m) { const int row = u.pm * BM + ai * HALF + wr * 64 + m * 16 + fr; const float rs = rstd_of(ss[row]);
#pragma unroll
                for (int bj = 0; bj < 2; ++bj) { const int col = u.pn * BM + bj * HALF + wc * 32 + 8 * fq;
                    const f32x4 v0 = acc[ai][bj][m][0] * rs, v1 = acc[ai][bj][m][1] * rs;
                    if (col < 1024) { *(f32x4*)(outK + (size_t)row * 1024 + col) = v0; *(f32x4*)(outK + (size_t)row * 1024 + col + 4) = v1;
                        u32x4 w; w.x = cvt_pk_bf16(v0[0], v0[1]); w.y = cvt_pk_bf16(v0[2], v0[3]); w.z = cvt_pk_bf16(v1[0], v1[1]); w.w = cvt_pk_bf16(v1[2], v1[3]);
                        *(u32x4*)(KB + (size_t)row * 1024 + col) = w; }
                    else { *(f32x4*)(outV + (size_t)row * 1024 + col - 1024) = v0; *(f32x4*)(outV + (size_t)row * 1024 + col - 1024 + 4) = v1; } } }
    }
};
struct EpiVT {
    static constexpr bool PERM = true, AFTER_DRAIN = false;
    bf16_t* VT; const float* ss;
    __device__ __forceinline__ void operator()(const f32x4 (&acc)[2][2][4][2], const Unit& u, int wr, int wc, int fr, int fq) const {
#pragma unroll
        for (int bj = 0; bj < 2; ++bj) { const int col = u.pn * BM + bj * HALF + wc * 32 + 8 * fq;
            const f32x4 s0 = *(const f32x4*)(ss + col), s1 = *(const f32x4*)(ss + col + 4);
            f32x4 r0, r1;
#pragma unroll
            for (int i = 0; i < 4; ++i) { r0[i] = rstd_of(s0[i]); r1[i] = rstd_of(s1[i]); }
#pragma unroll
            for (int ai = 0; ai < 2; ++ai)
#pragma unroll
                for (int m = 0; m < 4; ++m) { const int row = u.pm * BM + ai * HALF + wr * 64 + m * 16 + fr;
                    const f32x4 v0 = acc[ai][bj][m][0] * r0, v1 = acc[ai][bj][m][1] * r1;
                    u32x4 w; w.x = cvt_pk_bf16(v0[0], v0[1]); w.y = cvt_pk_bf16(v0[2], v0[3]); w.z = cvt_pk_bf16(v1[0], v1[1]); w.w = cvt_pk_bf16(v1[2], v1[3]);
                    *(u32x4*)(VT + (size_t)row * 2048 + col) = w; } }
    }
};
template <class Epi, class Sched, bool ALIGN_EPI = false, bool SP2 = false>
__device__ __forceinline__ void gemm_phase(PG8_LAS unsigned char* lds, const Gemm g, const Sched& S, const Epi& E) {
    const int tid = threadIdx.x, wid = __builtin_amdgcn_readfirstlane(tid >> 6), lane = tid & 63, wr = wid >> 2, wc = wid & 3, fr = lane & 15, fq = lane >> 4;
    const int K = g.K, nt = K / BK;
    unsigned voffA[2], voffB[2];
#pragma unroll
    for (int i = 0; i < 2; ++i) { int R, C; stage_rc(tid * 16 + i * 8192, R, C); const int Rb = Epi::PERM ? ((R & ~31) + perm32(R & 31)) : R;
        voffA[i] = (unsigned)(R * K + C) * 2u; voffB[i] = (unsigned)(Rb * K + C) * 2u; }
    const size_t kstep = (size_t)(BK * 2);
    const size_t hstep = (size_t)HALF * K * 2;
    const size_t tstep = 2 * hstep;
    const unsigned ldsw = (unsigned)wid * 1024u;
    const int aoff = lds_byte(wr * 64 + fr, fq * 8), boff = lds_byte(wc * 32 + fr, fq * 8);
#define PG8_SA(b, h) (((b) * 2 + (h)) * HTB)
#define PG8_SB(b, h) ((4 + (b) * 2 + (h)) * HTB)
#define PG8_STAGE(bufoff, gbase, voff) do { _Pragma("unroll") for (int _i = 0; _i < 2; ++_i) \
        __builtin_amdgcn_global_load_lds((const unsigned*)((const char*)(gbase) + (voff)[_i]), (PG8_LAS unsigned*)(lds + (bufoff) + ldsw + _i * 8192), 16, 0, 0); } while (0)
#define PG8_LDA(dst, b, h) do { _Pragma("unroll") for (int m = 0; m < 4; ++m) _Pragma("unroll") for (int k = 0; k < 2; ++k) dst[m][k] = *(const PG8_LAS bf16x8*)(lds + PG8_SA(b, h) + aoff + m * 2048 + k * 1024); } while (0)
#define PG8_LDB(dst, b, h) do { _Pragma("unroll") for (int n = 0; n < 2; ++n) _Pragma("unroll") for (int k = 0; k < 2; ++k) dst[n][k] = *(const PG8_LAS bf16x8*)(lds + PG8_SB(b, h) + boff + n * 2048 + k * 1024); } while (0)
#define PG8_MMA(ai, bj, At, Bt) do { __builtin_amdgcn_s_setprio(1); _Pragma("unroll") for (int m = 0; m < 4; ++m) _Pragma("unroll") for (int n = 0; n < 2; ++n) _Pragma("unroll") for (int k = 0; k < 2; ++k) \
        acc[ai][bj][m][n] = __builtin_amdgcn_mfma_f32_16x16x32_bf16(Bt[n][k], At[m][k], acc[ai][bj][m][n], 0, 0, 0); __builtin_amdgcn_s_setprio(0); } while (0)
#define PG8_WAIT_V(n) asm volatile("s_waitcnt vmcnt(" #n ")" ::: "memory")
#define PG8_WAIT_L(n) asm volatile("s_waitcnt lgkmcnt(" #n ")" ::: "memory")
#define PG8_BAR __builtin_amdgcn_s_barrier()
#define PG8_SCHED __builtin_amdgcn_sched_barrier(0)
    Unit cur, nxt; int ui = 0;
    if (!S.next(0, cur)) return;
    f32x4 acc[2][2][4][2];
#pragma unroll
    for (int a = 0; a < 2; ++a)
#pragma unroll
        for (int b = 0; b < 2; ++b)
#pragma unroll
            for (int m = 0; m < 4; ++m)
#pragma unroll
                for (int n = 0; n < 2; ++n) acc[a][b][m][n] = (f32x4){0.f, 0.f, 0.f, 0.f};
    bf16x8 At[4][2], B0[2][2], B1[2][2];
    const char* cA = (const char*)g.A + (size_t)cur.pm * tstep; const char* cB = (const char*)g.Bt + (size_t)cur.pn * tstep;
    S.a_ready(cur);
    if constexpr (SP2) {
        PG8_STAGE(PG8_SB(0, 0), cB, voffB); PG8_STAGE(PG8_SB(0, 1), cB + hstep, voffB); PG8_STAGE(PG8_SA(0, 0), cA, voffA); PG8_STAGE(PG8_SA(0, 1), cA + hstep, voffA);
        if (wr == 1) PG8_BAR;
        PG8_WAIT_V(2); PG8_BAR;
        PG8_STAGE(PG8_SB(1, 0), cB + kstep, voffB); PG8_STAGE(PG8_SA(1, 0), cA + kstep, voffA); PG8_STAGE(PG8_SB(1, 1), cB + hstep + kstep, voffB);
        PG8_WAIT_V(6); PG8_BAR;
    } else {
        PG8_STAGE(PG8_SB(0, 0), cB, voffB); PG8_STAGE(PG8_SA(0, 0), cA, voffA); PG8_STAGE(PG8_SB(0, 1), cB + hstep, voffB); PG8_STAGE(PG8_SA(0, 1), cA + hstep, voffA);
        if (wr == 1) PG8_BAR;
        PG8_WAIT_V(4); PG8_BAR;
        PG8_STAGE(PG8_SB(1, 0), cB + kstep, voffB); PG8_STAGE(PG8_SA(1, 0), cA + kstep, voffA); PG8_STAGE(PG8_SB(1, 1), cB + hstep + kstep, voffB);
        PG8_WAIT_V(6); PG8_BAR;
    }
    for (;;) {
        const bool has_next = S.next(ui + 1, nxt);
        const char* nA = has_next ? (const char*)g.A + (size_t)nxt.pm * tstep : cA; const char* nB = has_next ? (const char*)g.Bt + (size_t)nxt.pn * tstep : cB;
        for (int t = 0; t < nt; t += 2) {
            const bool last = (t == nt - 2);
            const char* a1 = cA + (size_t)(t + 1) * kstep;
            const char* a2 = last ? nA : cA + (size_t)(t + 2) * kstep; const char* b2 = last ? nB : cB + (size_t)(t + 2) * kstep;
            const char* a3 = a2 + kstep; const char* b3 = b2 + kstep;
            if (last && has_next) S.a_ready(nxt);
            if constexpr (SP2) {
            PG8_LDB(B0, 0, 0); PG8_LDB(B1, 0, 1); PG8_SCHED; PG8_LDA(At, 0, 0); PG8_STAGE(PG8_SA(1, 1), a1 + hstep, voffA);
            PG8_WAIT_V(8); PG8_WAIT_L(0); PG8_BAR; PG8_MMA(0, 0, At, B0); PG8_MMA(0, 1, At, B1); PG8_BAR; PG8_SCHED;
            PG8_LDA(At, 0, 1); PG8_STAGE(PG8_SB(0, 0), b2, voffB); PG8_STAGE(PG8_SB(0, 1), b2 + hstep, voffB); PG8_STAGE(PG8_SA(0, 0), a2, voffA);
            PG8_WAIT_V(8); PG8_WAIT_L(0); PG8_BAR; PG8_MMA(1, 0, At, B0); PG8_MMA(1, 1, At, B1); PG8_BAR; PG8_SCHED;
            PG8_LDB(B0, 1, 0); PG8_LDB(B1, 1, 1); PG8_SCHED; PG8_LDA(At, 1, 0); PG8_STAGE(PG8_SA(0, 1), a2 + hstep, voffA);
            PG8_WAIT_V(8); PG8_WAIT_L(0); PG8_BAR; PG8_MMA(0, 0, At, B0); PG8_MMA(0, 1, At, B1); PG8_BAR; PG8_SCHED;
            PG8_LDA(At, 1, 1); PG8_STAGE(PG8_SB(1, 0), b3, voffB); PG8_STAGE(PG8_SB(1, 1), b3 + hstep, voffB); PG8_STAGE(PG8_SA(1, 0), a3, voffA);
            PG8_WAIT_V(8); PG8_WAIT_L(0); PG8_BAR; PG8_MMA(1, 0, At, B0); PG8_MMA(1, 1, At, B1); PG8_BAR; PG8_SCHED;
            } else {
            PG8_LDB(B0, 0, 0); PG8_SCHED; PG8_LDA(At, 0, 0); PG8_STAGE(PG8_SA(1, 1), a1 + hstep, voffA);
            PG8_WAIT_L(8); PG8_BAR; PG8_WAIT_L(0); PG8_MMA(0, 0, At, B0); PG8_BAR; PG8_SCHED;
            PG8_LDB(B1, 0, 1); PG8_STAGE(PG8_SB(0, 0), b2, voffB);
            PG8_BAR; PG8_WAIT_L(0); PG8_MMA(0, 1, At, B1); PG8_BAR;
            PG8_LDA(At, 0, 1); PG8_STAGE(PG8_SA(0, 0), a2, voffA);
            PG8_BAR; PG8_WAIT_L(0); PG8_MMA(1, 0, At, B0); PG8_BAR; PG8_SCHED;
            PG8_STAGE(PG8_SB(0, 1), b2 + hstep, voffB);
            PG8_WAIT_V(6); PG8_BAR; PG8_MMA(1, 1, At, B1); PG8_BAR;
            PG8_LDB(B0, 1, 0); PG8_SCHED; PG8_LDA(At, 1, 0); PG8_STAGE(PG8_SA(0, 1), a2 + hstep, voffA);
            PG8_WAIT_L(8); PG8_BAR; PG8_WAIT_L(0); PG8_MMA(0, 0, At, B0); PG8_BAR; PG8_SCHED;
            PG8_LDB(B1, 1, 1); PG8_STAGE(PG8_SB(1, 0), b3, voffB);
            PG8_BAR; PG8_WAIT_L(0); PG8_MMA(0, 1, At, B1); PG8_BAR;
            PG8_LDA(At, 1, 1); PG8_STAGE(PG8_SA(1, 0), a3, voffA);
            PG8_BAR; PG8_WAIT_L(0); PG8_MMA(1, 0, At, B0); PG8_BAR; PG8_SCHED;
            PG8_STAGE(PG8_SB(1, 1), b3 + hstep, voffB);
            PG8_WAIT_V(6); PG8_BAR; PG8_MMA(1, 1, At, B1); PG8_BAR;
            }
        }
        if constexpr (ALIGN_EPI) { if (wr == 0) PG8_BAR; }
        if constexpr (!Epi::AFTER_DRAIN) { E(acc, cur, wr, wc, fr, fq); S.done(cur); }
        if (!has_next) break;
#pragma unroll
        for (int a = 0; a < 2; ++a)
#pragma unroll
            for (int b = 0; b < 2; ++b)
#pragma unroll
                for (int m = 0; m < 4; ++m)
#pragma unroll
                    for (int n = 0; n < 2; ++n) acc[a][b][m][n] = (f32x4){0.f, 0.f, 0.f, 0.f};
        cur = nxt; cA = nA; cB = nB; ++ui;
        if constexpr (ALIGN_EPI) { if (wr == 1) PG8_BAR; }
    }
    PG8_WAIT_V(0);
    if constexpr (!ALIGN_EPI) { if (wr == 0) PG8_BAR; }
    PG8_BAR;
    if constexpr (Epi::AFTER_DRAIN) { E.fused(acc, cur, wr, wc, fr, fq, lds, wid, lane); S.done(cur); }
#undef PG8_SA
#undef PG8_SB
#undef PG8_STAGE
#undef PG8_LDA
#undef PG8_LDB
#undef PG8_MMA
#undef PG8_WAIT_V
#undef PG8_WAIT_L
#undef PG8_BAR
#undef PG8_SCHED
}
}
using pg8::fsigmoid; using pg8::bf16_t; using pg8::bf16x8; using pg8::f32x4; using pg8::u32x4; using pg8::cvt_pk_bf16;
typedef unsigned u32x2 __attribute__((ext_vector_type(2)));
constexpr int MP = 16384, MS = 1024, MT = 17408, DM = 1024, FF = 2816, NGU = 5632, NIN = 1536;
constexpr int NTHR = 512, NWAVES = 8;
constexpr size_t OUT_Y = 0, OUT_PCONV = 17825792, OUT_PLRU = 17838080, OUT_PPOOL = 17842176, OUT_PMK = 17903616, OUT_PMV = 20000768,
                 OUT_SCONV = 22097920, OUT_SLRU = 22294528, OUT_SPOOL = 22360064, OUT_TOTAL = 23343104;
constexpr size_t al256(size_t x) { return (x + 255) & ~(size_t)255; }
constexpr size_t WS_BAR = 0;
constexpr size_t WS_SS = 16384;
constexpr size_t WS_SS_BYTES = 4 * (size_t)MT * 4;
constexpr size_t WS_SS0 = al256(WS_SS + WS_SS_BYTES);
constexpr size_t WS_SSM = al256(WS_SS0 + (size_t)MT * 4);
constexpr size_t WS_W1GU = al256(WS_SSM + 2048 * 4);
constexpr size_t WS_W1D = WS_W1GU + (size_t)NGU * DM * 2;
constexpr size_t WS_W2GU = WS_W1D + (size_t)DM * FF * 2;
constexpr size_t WS_W2D = WS_W2GU + (size_t)NGU * DM * 2;
constexpr size_t WS_WIN = WS_W2D + (size_t)DM * FF * 2;
constexpr size_t WS_WOUT = WS_WIN + (size_t)NIN * DM * 2;
constexpr size_t WS_WQ = WS_WOUT + (size_t)DM * DM * 2;
constexpr size_t WS_WKV = WS_WQ + (size_t)DM * DM * 2;
constexpr size_t WS_WO = WS_WKV + (size_t)2 * DM * DM * 2;
constexpr size_t WS_WAT = WS_WO + (size_t)DM * DM * 2;
constexpr size_t WS_WXT = WS_WAT + 8 * 64 * 64 * 2;
constexpr size_t WS_PWT = WS_WXT + 8 * 64 * 64 * 2;
constexpr size_t WS_XB = al256(WS_PWT + 4 * 128 * 128 * 2);
constexpr size_t WS_X = WS_XB + (size_t)MT * DM * 2;
constexpr size_t WS_H = WS_X + (size_t)MT * DM * 4;
constexpr size_t WS_PROJ = WS_H + (size_t)MT * FF * 2;
constexpr size_t WS_MEMB = WS_PROJ + (size_t)MT * NIN * 2;
constexpr size_t WS_KB = WS_MEMB + (size_t)2048 * DM * 2;
constexpr size_t WS_VT = WS_KB + (size_t)2048 * DM * 2;
constexpr size_t WS_Y = WS_VT + (size_t)2048 * DM * 2;
constexpr size_t WS_Q = WS_Y + (size_t)MT * DM * 2;
constexpr size_t WS_O = WS_Q + (size_t)MT * DM * 2;
constexpr size_t WS_HSL = WS_O + (size_t)MT * DM * 2;
constexpr size_t WS_PP = WS_HSL + (size_t)MT * 512 * 2;
constexpr size_t WS_SUMH = WS_PP + (size_t)MT * 512 * 2;
constexpr size_t WS_SUMP = WS_SUMH + (size_t)8 * 32 * 512 * 4;
constexpr size_t WS_END = WS_SUMP + (size_t)8 * 32 * 512 * 4;

#define LAS __attribute__((address_space(3)))
struct Args { const float* in[35]; float* out; unsigned char* ws; };

__device__ __forceinline__ float bf2f(bf16_t v) { return __uint_as_float((unsigned)v << 16); }
__device__ __forceinline__ bf16_t f2bf(float f) { unsigned u = __float_as_uint(f); u += 0x7fffu + ((u >> 16) & 1u); return (bf16_t)(u >> 16); }
__device__ __forceinline__ void wave_lds_sync() { asm volatile("s_waitcnt lgkmcnt(0)" ::: "memory"); }
__device__ __forceinline__ float wave_sum(float v) {
#pragma unroll
    for (int o = 1; o < 64; o <<= 1) v += __shfl_xor(v, o);
    return v;
}
__device__ __forceinline__ float wave_max(float v) {
#pragma unroll
    for (int o = 1; o < 64; o <<= 1) v = fmaxf(v, __shfl_xor(v, o));
    return v;
}
__device__ __forceinline__ f32x4 mfma16(bf16x8 a, bf16x8 b, f32x4 c) { return __builtin_amdgcn_mfma_f32_16x16x32_bf16(a, b, c, 0, 0, 0); }

__device__ __forceinline__ void tr_item(const float* W, int K, int N, const float* g, bf16_t* WT, int grp, int gmul, int goff, float* scr, int item, int lane) {
    const int nblk = N / 64, kb = item / nblk, nb = item % nblk, k0 = 64 * kb, n0 = 64 * nb; const int lr = lane >> 4, lc = (lane & 15) * 4;
    f32x4 v[16];
#pragma unroll
    for (int i = 0; i < 16; ++i) v[i] = *(const f32x4*)(W + (size_t)(k0 + 4 * i + lr) * N + n0 + lc);
#pragma unroll
    for (int i = 0; i < 16; ++i) { const int k = 4 * i + lr; const float gg = g ? g[k0 + k] : 1.0f; float* d = scr + k * 65 + lc; d[0] = v[i][0] * gg; d[1] = v[i][1] * gg; d[2] = v[i][2] * gg; d[3] = v[i][3] * gg; }
    wave_lds_sync();
    const int c = lane & 7;
#pragma unroll
    for (int j = 0; j < 8; ++j) { const int n = (lane >> 3) + 8 * j; const float* s = scr + (8 * c) * 65 + n; const int nn = n0 + n; const int dr = (nn / grp) * gmul + goff + nn % grp;
        u32x4 o; o.x = cvt_pk_bf16(s[0 * 65], s[1 * 65]); o.y = cvt_pk_bf16(s[2 * 65], s[3 * 65]); o.z = cvt_pk_bf16(s[4 * 65], s[5 * 65]); o.w = cvt_pk_bf16(s[6 * 65], s[7 * 65]);
        *(u32x4*)(WT + (size_t)dr * K + k0 + 8 * c) = o; }
    wave_lds_sync();
}
__device__ __forceinline__ void row_to_bf16(const float* xrow, bf16_t* orow, float* ssout, int lane) {
    const f32x4* xr = (const f32x4*)xrow + lane; f32x4 v[4]; float s = 0.f;
#pragma unroll
    for (int j = 0; j < 4; ++j) { v[j] = xr[64 * j]; s += (v[j][0] * v[j][0] + v[j][1] * v[j][1]) + (v[j][2] * v[j][2] + v[j][3] * v[j][3]); }
    s = wave_sum(s);
    u32x2* o8 = (u32x2*)orow + lane;
#pragma unroll
    for (int j = 0; j < 4; ++j) { u32x2 w; w.x = cvt_pk_bf16(v[j][0], v[j][1]); w.y = cvt_pk_bf16(v[j][2], v[j][3]); o8[64 * j] = w; }
    if (lane == 0) *ssout = s;
}
#define XB_TMO      128
#define XB_XCNT(j)  (256  + 64 * (j))
#define XB_XSUB(j)  (1280 + 64 * (j))
#define XB_XGEN(j)  (2304 + 64 * (j))
#define XB_TOP      3328
#define XB_TOPGEN   3392
#define XCD_BAR_WORDS 3456
#define XB_SPIN_CAP (1u << 18)

__device__ __forceinline__ unsigned xb_ld(unsigned* p)              { return __hip_atomic_load(p, __ATOMIC_RELAXED, __HIP_MEMORY_SCOPE_AGENT); }
__device__ __forceinline__ unsigned xb_add(unsigned* p, unsigned v) { return __hip_atomic_fetch_add(p, v, __ATOMIC_RELAXED, __HIP_MEMORY_SCOPE_AGENT); }
__device__ __forceinline__ unsigned xb_xcc_id() { return (unsigned)__builtin_amdgcn_s_getreg((3 << 11) | 20) & 0xFu; }
#define XB_SPIN(cond, bar) do { unsigned _sp = 0; while (cond) { __builtin_amdgcn_s_sleep(1); \
    if ((++_sp & 255u) == 0u) { if (xb_ld(&(bar)[XB_TMO])) break; if (_sp > XB_SPIN_CAP) { atomicAdd(&(bar)[XB_TMO], 1u); break; } } } } while (0)

struct XcdBarrier {
    unsigned* bar; unsigned x;
    volatile LAS unsigned* st;
};

__device__ __forceinline__ XcdBarrier xcd_barrier_post(unsigned* bar, volatile LAS unsigned* st) {
    XcdBarrier b; b.bar = bar; b.x = xb_xcc_id(); b.st = st;
    if (threadIdx.x == 0) (void)xb_add(&bar[XB_XCNT(b.x)], 1u);
    return b;
}
__device__ __forceinline__ void xcd_barrier_complete(unsigned* bar, unsigned x, unsigned& nloc, unsigned& nx) {
    const unsigned G = gridDim.x * gridDim.y * gridDim.z;
    unsigned sum, cnt, mine, sp = 0u;
    for (;;) {
        sum = 0u; cnt = 0u; mine = 0u;
#pragma unroll
        for (unsigned j = 0; j < 16; ++j) { const unsigned c = xb_ld(&bar[XB_XCNT(j)]); sum += c; cnt += (c > 0u) ? 1u : 0u; mine = (j == x) ? c : mine; }
        if (sum == G) break;
        __builtin_amdgcn_s_sleep(1);
        if ((++sp & 255u) == 0u) { if (xb_ld(&bar[XB_TMO])) break; if (sp > XB_SPIN_CAP) { atomicAdd(&bar[XB_TMO], 1u); break; } }
    }
    nloc = mine > 0u ? mine : 1u; nx = cnt > 0u ? cnt : 1u;
}

__device__ __forceinline__ void xcd_barrier(const XcdBarrier& b) {
    asm volatile("s_waitcnt vmcnt(0)" ::: "memory");
    __syncthreads();
    if (threadIdx.x == 0) {
        unsigned* bar = b.bar;
        __builtin_amdgcn_s_waitcnt(0);
        unsigned nloc = b.st[0], nx = b.st[1];
        if (nloc == 0u) { xcd_barrier_complete(bar, b.x, nloc, nx); b.st[0] = nloc; b.st[1] = nx; }
        const unsigned old = xb_add(&bar[XB_XSUB(b.x)], 1u);
        const unsigned gen = old / nloc;
        if (old + 1u == (gen + 1u) * nloc) {
            __builtin_amdgcn_fence(__ATOMIC_RELEASE, "agent");
            asm volatile("s_waitcnt vmcnt(0)" ::: "memory");
            const unsigned og = xb_add(&bar[XB_TOP], 1u);
            const unsigned tg = og / nx;
            if (og + 1u == (tg + 1u) * nx) xb_add(&bar[XB_TOPGEN], 1u);
            else XB_SPIN(xb_ld(&bar[XB_TOPGEN]) == tg, bar);
            __builtin_amdgcn_fence(__ATOMIC_ACQUIRE, "agent");
            xb_add(&bar[XB_XGEN(b.x)], 1u);
            asm volatile("s_waitcnt vmcnt(0)" ::: "memory");
        } else {
            XB_SPIN(xb_ld(&bar[XB_XGEN(b.x)]) == gen, bar);
            __builtin_amdgcn_fence(__ATOMIC_ACQUIRE, "agent");
            asm volatile("s_waitcnt vmcnt(0)" ::: "memory");
        }
    }
    __syncthreads();
}
struct MixP {
    const bf16_t* PROJ; const float *conv_w, *conv_b, *lru_ba, *lru_bx, *lru_lambda, *state_conv, *state_lru, *state_pool, *pool_scale;
    const bf16_t *WaT, *WxT, *PwT; bf16_t *HSL, *PP, *Y; float *SUMH, *SUMP; float *o_pconv, *o_plru, *o_ppool, *o_sconv, *o_slru, *o_spool;
};
__device__ __forceinline__ void mixer1(const MixP& p, unsigned char* lds, int wid, int lane) {
    unsigned char* wl = lds + wid * 12288;
    bf16_t* UC = (bf16_t*)wl; float* A2 = (float*)(wl + 2304); float* B2 = (float*)(wl + 2304 + 4352); float* TAB = (float*)(wl + 2304 + 8704);
    const int ch = wid * 64 + lane, fr = lane & 15, fq = lane >> 4;
    TAB[lane] = p.lru_ba[ch]; TAB[64 + lane] = p.lru_bx[ch]; TAB[128 + lane] = -8.0f * log1pf(expf(-p.lru_lambda[ch]));
    const float cw0 = p.conv_w[ch], cw1 = p.conv_w[512 + ch], cw2 = p.conv_w[1024 + ch], cw3 = p.conv_w[1536 + ch], cb = p.conv_b[ch];
    bf16x8 XA[4][2], XI[4][2];
#pragma unroll
    for (int n = 0; n < 4; ++n)
#pragma unroll
        for (int kk = 0; kk < 2; ++kk) { XA[n][kk] = *(const bf16x8*)(p.WaT + wid * 4096 + (16 * n + fr) * 64 + 8 * fq + 32 * kk); XI[n][kk] = *(const bf16x8*)(p.WxT + wid * 4096 + (16 * n + fr) * 64 + 8 * fq + 32 * kk); }
    wave_lds_sync();
    for (int unit = blockIdx.x; unit < 320; unit += gridDim.x) {
        const bool smp = unit >= 256; const int b = unit >> 5, c = unit & 31; const int sbase = (unit - 256) * 2;
        const int R0 = smp ? MP + (unit - 256) * 16 : b * 2048 + c * 64; const int nq = smp ? 1 : 4;
        float u1 = 0.f, u2 = 0.f, u3 = 0.f, h = 0.f, Pc = 1.0f;
        if (!smp && c > 0) { u1 = bf2f(p.PROJ[(size_t)(R0 - 1) * NIN + ch]); u2 = bf2f(p.PROJ[(size_t)(R0 - 2) * NIN + ch]); u3 = bf2f(p.PROJ[(size_t)(R0 - 3) * NIN + ch]); }
        for (int q4 = 0; q4 < nq; ++q4) {
#pragma unroll
            for (int i = 0; i < 16; ++i) { const int t = 16 * q4 + i; const int row = R0 + t;
                if (smp && (i & 7) == 0) { const float* sc = p.state_conv + (size_t)(sbase + (t >> 3)) * 1536 + ch; u3 = sc[0]; u2 = sc[512]; u1 = sc[1024]; }
                const float u = bf2f(p.PROJ[(size_t)row * NIN + ch]);
                const float uc = cb + cw3 * u + cw2 * u1 + cw1 * u2 + cw0 * u3; u3 = u2; u2 = u1; u1 = u;
                UC[i * 72 + lane] = f2bf(uc);
                if (smp) { if ((i & 7) >= 5) p.o_sconv[((size_t)(sbase + (t >> 3)) * 3 + ((i & 7) - 5)) * 512 + ch] = u; }
                else if (c == 31 && t >= 61) p.o_pconv[((size_t)b * 3 + (t - 61)) * 512 + ch] = u;
            }
            wave_lds_sync();
            const bf16x8 Y0 = *(const bf16x8*)(UC + fr * 72 + 8 * fq), Y1 = *(const bf16x8*)(UC + fr * 72 + 8 * fq + 32);
#pragma unroll
            for (int n = 0; n < 4; ++n) { f32x4 aR = {0.f, 0.f, 0.f, 0.f}, aI = {0.f, 0.f, 0.f, 0.f};
                aR = mfma16(XA[n][0], Y0, aR); aR = mfma16(XA[n][1], Y1, aR); aI = mfma16(XI[n][0], Y0, aI); aI = mfma16(XI[n][1], Y1, aI);
                const int j0 = 16 * n + 4 * fq; const f32x4 ba4 = *(const f32x4*)(TAB + j0), bx4 = *(const f32x4*)(TAB + 64 + j0), sp4 = *(const f32x4*)(TAB + 128 + j0);
                const u32x2 ucw = *(const u32x2*)(UC + fr * 72 + j0);
                const float ucv[4] = {__uint_as_float(ucw.x << 16), __uint_as_float(ucw.x & 0xffff0000u), __uint_as_float(ucw.y << 16), __uint_as_float(ucw.y & 0xffff0000u)};
                f32x4 a4, b4;
#pragma unroll
                for (int i = 0; i < 4; ++i) { const float r = fsigmoid(aR[i] + ba4[i]), ig = fsigmoid(aI[i] + bx4[i]); const float a = __expf(sp4[i] * r);
                    const float mult = sqrtf(fmaxf(1.0f - a * a, 0.f)); a4[i] = a; b4[i] = mult * ig * ucv[i]; }
                *(f32x4*)(A2 + fr * 68 + j0) = a4; *(f32x4*)(B2 + fr * 68 + j0) = b4; }
            wave_lds_sync();
#pragma unroll
            for (int i = 0; i < 16; ++i) { const int t = 16 * q4 + i; const int row = R0 + t;
                if (smp && (i & 7) == 0) h = p.state_lru[(size_t)(sbase + (t >> 3)) * 512 + ch];
                const float a = A2[i * 68 + lane], bb = B2[i * 68 + lane]; h = a * h + bb; Pc *= a;
                p.HSL[(size_t)row * 512 + ch] = f2bf(h); p.PP[(size_t)row * 512 + ch] = smp ? (bf16_t)0 : f2bf(Pc);
                if (smp && (i & 7) == 7) p.o_slru[(size_t)(sbase + (t >> 3)) * 512 + ch] = h; }
            wave_lds_sync();
        }
        if (!smp) { p.SUMH[(size_t)(b * 32 + c) * 512 + ch] = h; p.SUMP[(size_t)(b * 32 + c) * 512 + ch] = Pc; }
    }
}
__device__ __forceinline__ float gelu_tanh(float x) { const float z = 1.5957691216f * (x + 0.044715f * x * x * x); return x * fsigmoid(z); }
__device__ __forceinline__ void mixer2(const MixP& p, unsigned char* lds, int wid, int lane) {
    const int tid = wid * 64 + lane, fr = lane & 15, fq = lane >> 4;
    bf16_t* DL = (bf16_t*)lds;
    const int G_ = gridDim.x, cu_ = blockIdx.x; const bool remap = (G_ == 256);
    const int nmine = remap ? (((cu_ & 31) < 8) ? 2 : 1) : ((320 - cu_ + G_ - 1) / G_);
    for (int ui = 0; ui < nmine; ++ui) {
        const int unit = remap ? (ui == 0 ? cu_ : 256 + (cu_ >> 5) * 8 + (cu_ & 31)) : cu_ + ui * G_;
        const bool smp = unit >= 256; const int b = unit >> 5, c = unit & 31; const int sbase = (unit - 256) * 2;
        const int R0 = smp ? MP + (unit - 256) * 16 : b * 2048 + c * 64;
        { float carry[8];
#pragma unroll
          for (int k = 0; k < 8; ++k) carry[k] = 0.f;
          if (!smp) {
#pragma unroll 4
              for (int cc = 0; cc < c; ++cc) { const float* sh = p.SUMH + (size_t)(b * 32 + cc) * 512 + 8 * lane; const float* sp = p.SUMP + (size_t)(b * 32 + cc) * 512 + 8 * lane;
                  const f32x4 h0 = *(const f32x4*)sh, h1 = *(const f32x4*)(sh + 4), p0 = *(const f32x4*)sp, p1 = *(const f32x4*)(sp + 4);
#pragma unroll
                  for (int k = 0; k < 4; ++k) { carry[k] = h0[k] + p0[k] * carry[k]; carry[4 + k] = h1[k] + p1[k] * carry[4 + k]; } }
              if (c == 31 && wid == 0) { const float* sh = p.SUMH + (size_t)(b * 32 + 31) * 512 + 8 * lane; const float* sp = p.SUMP + (size_t)(b * 32 + 31) * 512 + 8 * lane;
                  const f32x4 h0 = *(const f32x4*)sh, h1 = *(const f32x4*)(sh + 4), p0 = *(const f32x4*)sp, p1 = *(const f32x4*)(sp + 4); f32x4 o0, o1;
#pragma unroll
                  for (int k = 0; k < 4; ++k) { o0[k] = h0[k] + p0[k] * carry[k]; o1[k] = h1[k] + p1[k] * carry[4 + k]; }
                  *(f32x4*)(p.o_plru + (size_t)b * 512 + 8 * lane) = o0; *(f32x4*)(p.o_plru + (size_t)b * 512 + 8 * lane + 4) = o1; } }
          const int nrr = smp ? 2 : 8;
#pragma unroll 2
          for (int rr = 0; rr < nrr; ++rr) { const int row = R0 + nrr * wid + rr;
              const u32x4 hw = *(const u32x4*)(p.HSL + (size_t)row * 512 + 8 * lane), pw = *(const u32x4*)(p.PP + (size_t)row * 512 + 8 * lane), gw = *(const u32x4*)(p.PROJ + (size_t)row * NIN + 512 + 8 * lane);
              unsigned ow[4];
#pragma unroll
              for (int k = 0; k < 4; ++k) { const unsigned hh = hw[k], pq = pw[k], gg = gw[k];
                  const float hs0 = __uint_as_float(hh << 16) + __uint_as_float(pq << 16) * carry[2 * k], hs1 = __uint_as_float(hh & 0xffff0000u) + __uint_as_float(pq & 0xffff0000u) * carry[2 * k + 1];
                  ow[k] = cvt_pk_bf16(gelu_tanh(__uint_as_float(gg << 16)) * hs0, gelu_tanh(__uint_as_float(gg & 0xffff0000u)) * hs1); }
              u32x4 o; o.x = ow[0]; o.y = ow[1]; o.z = ow[2]; o.w = ow[3];
              *(u32x4*)(p.Y + (size_t)row * 1024 + 8 * lane) = o; } }
        const int DLR0 = smp ? 0 : 15;
        if (smp) { const int ch = wid * 64 + lane, g = wid >> 1, win = 2 << g; const float rw = 1.0f / (float)win;
#pragma unroll 1
          for (int seg = 0; seg < 2; ++seg) { const int s = sbase + seg; float v[23];
#pragma unroll
              for (int e = 0; e < 15; ++e) v[e] = p.state_pool[((size_t)s * 15 + e) * 512 + ch];
#pragma unroll
              for (int e = 15; e < 23; ++e) v[e] = bf2f(p.PROJ[(size_t)(MP + s * 8 + e - 15) * NIN + 1024 + ch]);
#pragma unroll
              for (int t = 0; t < 8; ++t) { const float S2 = v[15 + t] + v[14 + t], S4 = S2 + (v[13 + t] + v[12 + t]), S8 = S4 + ((v[11 + t] + v[10 + t]) + (v[9 + t] + v[8 + t]));
                  const float S16 = S8 + (((v[7 + t] + v[6 + t]) + (v[5 + t] + v[4 + t])) + ((v[3 + t] + v[2 + t]) + (v[1 + t] + v[t])));
                  const float S = g == 0 ? S2 : (g == 1 ? S4 : (g == 2 ? S8 : S16));
                  DL[(seg * 8 + t) * 520 + ch] = f2bf(S * rw - v[15 + t]);
                  p.o_spool[((size_t)s * 15 + 7 + t) * 512 + ch] = v[15 + t]; }
#pragma unroll
              for (int k = 0; k < 7; ++k) p.o_spool[((size_t)s * 15 + k) * 512 + ch] = v[8 + k];
          } }
        else { const int ch = wid * 64 + lane, g = wid >> 1, win = 2 << g; const int t0 = c * 64;
          for (int i = tid; i < 79 * 64; i += NTHR) { const int e = i >> 6, cc = i & 63; const int tok = t0 + e - 15; u32x4 v = {0u, 0u, 0u, 0u};
              if (tok >= 0) v = *(const u32x4*)(p.PROJ + (size_t)(b * 2048 + tok) * NIN + 1024 + cc * 8);
              *(u32x4*)(DL + e * 520 + cc * 8) = v; }
          __syncthreads();
          float S = 0.f;
          for (int j = 0; j < win; ++j) S += bf2f(DL[(78 - j) * 520 + ch]);
#pragma unroll 8
          for (int t = 63; t >= 0; --t) { const int e = 15 + t; const float ut = bf2f(DL[e * 520 + ch]); const float cnt = (float)min(t0 + t + 1, win);
              DL[e * 520 + ch] = f2bf(S * __builtin_amdgcn_rcpf(cnt) - ut);
              if (t > 0) S = S - ut + bf2f(DL[(e - win) * 520 + ch]);
              if (c == 31 && t >= 49) p.o_ppool[((size_t)b * 15 + (t - 49)) * 512 + ch] = ut; }
        }
        __syncthreads();
        { const int g = wid >> 1, jh = wid & 1;
#pragma unroll 1
          for (int n = 0; n < 4; ++n) { bf16x8 X[4];
#pragma unroll
              for (int kk = 0; kk < 4; ++kk) X[kk] = *(const bf16x8*)(p.PwT + (size_t)g * 16384 + (64 * jh + 16 * n + fr) * 128 + 8 * fq + 32 * kk);
              const int j0 = g * 128 + 64 * jh + 16 * n + 4 * fq; const f32x4 sc4 = *(const f32x4*)(p.pool_scale + j0);
              const int nm = smp ? 1 : 4;
              for (int m = 0; m < nm; ++m) { f32x4 acc = {0.f, 0.f, 0.f, 0.f};
#pragma unroll
                  for (int kk = 0; kk < 4; ++kk) { const bf16x8 Yf = *(const bf16x8*)(DL + (DLR0 + 16 * m + fr) * 520 + g * 128 + 8 * fq + 32 * kk); acc = mfma16(X[kk], Yf, acc); }
                  u32x2 w; w.x = cvt_pk_bf16(acc[0] * sc4[0], acc[1] * sc4[1]); w.y = cvt_pk_bf16(acc[2] * sc4[2], acc[3] * sc4[3]);
                  *(u32x2*)(p.Y + (size_t)(R0 + 16 * m + fr) * 1024 + 512 + j0) = w; } } }
        __syncthreads();
    }
}
struct AttP { const bf16_t *Q, *KB, *VT; bf16_t* O; const float *cache_k, *cache_v; };
constexpr int ASTR = 528;
__device__ __forceinline__ void attn_prompt(const AttP& p, unsigned char* lds, int wid, int lane) {
    const int tid = wid * 64 + lane, fr = lane & 15, fq = lane >> 4;
    for (int unit = blockIdx.x; unit < 256; unit += gridDim.x) {
        const int b = unit >> 5, h = (unit >> 3) & 3, qb = unit & 7;
        const int rowbase = b * 2048 + qb * 256 + wid * 32;
        for (int i = tid; i < 256 * 32; i += NTHR) { const int r = i >> 5, cc = i & 31; *(u32x4*)(lds + r * ASTR + cc * 16) = *(const u32x4*)(p.KB + (size_t)(b * 256 + r) * 1024 + h * 256 + cc * 8); }
        const bf16_t* qp = p.Q + (size_t)(rowbase + fr) * 1024 + h * 256 + 8 * fq;
        bf16x8 Qf[2][8];
#pragma unroll
        for (int kk = 0; kk < 8; ++kk) { Qf[0][kk] = *(const bf16x8*)(qp + 32 * kk); Qf[1][kk] = *(const bf16x8*)(qp + 16 * 1024 + 32 * kk); }
        __syncthreads();
        bf16x8 Pf[8][2]; float mxc[2][2], smc[2][2];
#pragma unroll
        for (int kh = 0; kh < 2; ++kh) {
            f32x4 S[8][2];
#pragma unroll
            for (int n = 0; n < 8; ++n) { S[n][0] = (f32x4){0.f, 0.f, 0.f, 0.f}; S[n][1] = (f32x4){0.f, 0.f, 0.f, 0.f}; }
#pragma unroll
            for (int kk = 0; kk < 8; ++kk) { const bf16x8 q0 = Qf[0][kk], q1 = Qf[1][kk];
#pragma unroll
                for (int n = 0; n < 8; ++n) { const bf16x8 kf = *(const bf16x8*)(lds + (128 * kh + 16 * n + fr) * ASTR + (32 * kk + 8 * fq) * 2); S[n][0] = mfma16(kf, q0, S[n][0]); S[n][1] = mfma16(kf, q1, S[n][1]); }
                __builtin_amdgcn_sched_barrier(0); }
#pragma unroll
            for (int m = 0; m < 2; ++m) { float mx = -3.0e38f;
#pragma unroll
                for (int n = 0; n < 8; ++n) mx = fmaxf(mx, fmaxf(fmaxf(S[n][m][0], S[n][m][1]), fmaxf(S[n][m][2], S[n][m][3])));
                mx = fmaxf(mx, __shfl_xor(mx, 16)); mx = fmaxf(mx, __shfl_xor(mx, 32));
                float sum = 0.f;
#pragma unroll
                for (int n = 0; n < 8; ++n)
#pragma unroll
                    for (int i = 0; i < 4; ++i) { const float e = __builtin_amdgcn_exp2f(S[n][m][i] - mx); S[n][m][i] = e; sum += e; }
                sum += __shfl_xor(sum, 16); sum += __shfl_xor(sum, 32); mxc[kh][m] = mx; smc[kh][m] = sum; }
#pragma unroll
            for (int k2 = 0; k2 < 4; ++k2)
#pragma unroll
                for (int m = 0; m < 2; ++m) { u32x4 w; w.x = cvt_pk_bf16(S[2 * k2][m][0], S[2 * k2][m][1]); w.y = cvt_pk_bf16(S[2 * k2][m][2], S[2 * k2][m][3]);
                    w.z = cvt_pk_bf16(S[2 * k2 + 1][m][0], S[2 * k2 + 1][m][1]); w.w = cvt_pk_bf16(S[2 * k2 + 1][m][2], S[2 * k2 + 1][m][3]); Pf[4 * kh + k2][m] = __builtin_bit_cast(bf16x8, w); }
            __builtin_amdgcn_sched_barrier(0);
        }
        float rr[2], fin[2];
#pragma unroll
        for (int m = 0; m < 2; ++m) { const float mm = fmaxf(mxc[0][m], mxc[1][m]); const float c0 = __builtin_amdgcn_exp2f(mxc[0][m] - mm), c1 = __builtin_amdgcn_exp2f(mxc[1][m] - mm);
            rr[m] = __builtin_amdgcn_exp2f(fminf(fmaxf(mxc[0][m] - mxc[1][m], -80.f), 80.f)); fin[m] = c1 / (smc[0][m] * c0 + smc[1][m] * c1); }
        __syncthreads();
        for (int i = tid; i < 256 * 32; i += NTHR) { const int r = i >> 5, cc = i & 31; *(u32x4*)(lds + r * ASTR + cc * 16) = *(const u32x4*)(p.VT + (size_t)(h * 256 + r) * 2048 + b * 256 + cc * 8); }
        __syncthreads();
#pragma unroll 1
        for (int dh = 0; dh < 2; ++dh) { f32x4 O[8][2];
#pragma unroll
            for (int dn = 0; dn < 8; ++dn) { O[dn][0] = (f32x4){0.f, 0.f, 0.f, 0.f}; O[dn][1] = (f32x4){0.f, 0.f, 0.f, 0.f};
                const unsigned char* vrow = lds + (dh * 128 + dn * 16 + fr) * ASTR;
#pragma unroll
                for (int k2 = 0; k2 < 8; ++k2) { const u32x2 lo = *(const u32x2*)(vrow + (32 * k2 + 4 * fq) * 2), hi = *(const u32x2*)(vrow + (32 * k2 + 16 + 4 * fq) * 2);
                    u32x4 w; w.x = lo.x; w.y = lo.y; w.z = hi.x; w.w = hi.y; const bf16x8 vf = __builtin_bit_cast(bf16x8, w);
                    if (k2 == 4) { O[dn][0] = O[dn][0] * rr[0]; O[dn][1] = O[dn][1] * rr[1]; }
                    O[dn][0] = mfma16(vf, Pf[k2][0], O[dn][0]); O[dn][1] = mfma16(vf, Pf[k2][1], O[dn][1]); }
                __builtin_amdgcn_sched_barrier(0); }
#pragma unroll
            for (int dn = 0; dn < 8; ++dn)
#pragma unroll
                for (int m = 0; m < 2; ++m) { const f32x4 o = O[dn][m] * fin[m]; u32x2 w; w.x = cvt_pk_bf16(o[0], o[1]); w.y = cvt_pk_bf16(o[2], o[3]);
                    *(u32x2*)(p.O + (size_t)(rowbase + 16 * m + fr) * 1024 + h * 256 + dh * 128 + dn * 16 + 4 * fq) = w; } }
        __syncthreads();
    }
}
__device__ __forceinline__ void attn_sample(const AttP& p, unsigned char* lds, int wid, int lane) {
    const int tid = wid * 64 + lane, fr = lane & 15, fq = lane >> 4;
    float* SS = (float*)lds;
    float* PT = (float*)(lds + 8320);
    float* OP = (float*)(lds + 16640);
    for (int unit = blockIdx.x; unit < 512; unit += gridDim.x) {
        const int s = unit >> 2, h = unit & 3;
        bf16x8 Qf[8];
#pragma unroll
        for (int kk = 0; kk < 8; ++kk) { u32x4 w = {0u, 0u, 0u, 0u}; if (fr < 8) w = *(const u32x4*)(p.Q + (size_t)(MP + 8 * s + fr) * 1024 + h * 256 + 32 * kk + 8 * fq); Qf[kk] = __builtin_bit_cast(bf16x8, w); }
#pragma unroll
        for (int n = 0; n < 2; ++n) { const int key = 32 * wid + 16 * n + fr; const float* kp = p.cache_k + (((size_t)(s * 256 + key)) * 4 + h) * 256 + 8 * fq;
            f32x4 acc = {0.f, 0.f, 0.f, 0.f};
#pragma unroll
            for (int kk = 0; kk < 8; ++kk) { const f32x4 a0 = *(const f32x4*)(kp + 32 * kk), a1 = *(const f32x4*)(kp + 32 * kk + 4);
                u32x4 w; w.x = cvt_pk_bf16(a0[0], a0[1]); w.y = cvt_pk_bf16(a0[2], a0[3]); w.z = cvt_pk_bf16(a1[0], a1[1]); w.w = cvt_pk_bf16(a1[2], a1[3]);
                acc = mfma16(__builtin_bit_cast(bf16x8, w), Qf[kk], acc); }
            if (fr < 8) *(f32x4*)(SS + fr * 260 + 32 * wid + 16 * n + 4 * fq) = acc; }
        __syncthreads();
        { const f32x4 v = *(const f32x4*)(SS + wid * 260 + 4 * lane);
          const float mx = wave_max(fmaxf(fmaxf(v[0], v[1]), fmaxf(v[2], v[3])));
          f32x4 e; float sum = 0.f;
#pragma unroll
          for (int i = 0; i < 4; ++i) { e[i] = __builtin_amdgcn_exp2f(v[i] - mx); sum += e[i]; }
          sum = wave_sum(sum); const float is = 1.0f / sum;
#pragma unroll
          for (int i = 0; i < 4; ++i) PT[(4 * lane + i) * 8 + wid] = e[i] * is; }
        __syncthreads();
        { float o[8][4];
#pragma unroll
          for (int q = 0; q < 8; ++q)
#pragma unroll
              for (int i = 0; i < 4; ++i) o[q][i] = 0.f;
          const float* vp = p.cache_v + (((size_t)(s * 256 + 32 * wid)) * 4 + h) * 256 + 4 * lane;
#pragma unroll 16
          for (int kq = 0; kq < 32; ++kq) { const f32x4 v = *(const f32x4*)(vp + (size_t)kq * 1024); const f32x4 pa = *(const f32x4*)(PT + (32 * wid + kq) * 8), pb = *(const f32x4*)(PT + (32 * wid + kq) * 8 + 4);
#pragma unroll
              for (int q = 0; q < 4; ++q)
#pragma unroll
                  for (int i = 0; i < 4; ++i) { o[q][i] += pa[q] * v[i]; o[4 + q][i] += pb[q] * v[i]; } }
#pragma unroll
          for (int q = 0; q < 8; ++q) *(f32x4*)(OP + (size_t)(wid * 8 + q) * 256 + 4 * lane) = (f32x4){o[q][0], o[q][1], o[q][2], o[q][3]}; }
        __syncthreads();
        { const int q = tid >> 6, d4 = (tid & 63) * 4; f32x4 a = {0.f, 0.f, 0.f, 0.f};
#pragma unroll
          for (int w = 0; w < 8; ++w) a += *(const f32x4*)(OP + (size_t)(w * 8 + q) * 256 + d4);
          u32x2 ww; ww.x = cvt_pk_bf16(a[0], a[1]); ww.y = cvt_pk_bf16(a[2], a[3]);
          *(u32x2*)(p.O + (size_t)(MP + 8 * s + q) * 1024 + h * 256 + d4) = ww; }
        __syncthreads();
    }
}
struct SmallEpi { int mode; const bf16_t* xin; float* xout; bf16_t* xb; float* ss; float alpha; bf16_t* O; const float* ssin; float mul; };
__device__ __forceinline__ void small_gemm(unsigned char* lds, const bf16_t* A, const bf16_t* Bt, int K, const SmallEpi& E, int wid, int lane) {
    const int tid = wid * 64 + lane, fr = lane & 15, fq = lane >> 4;
    float* RED = (float*)lds;
    for (int t = blockIdx.x; t < 256; t += gridDim.x) {
        const int r0 = (t >> 4) * 64, c0 = (t & 15) * 64; const int np = K >> 6, base = np >> 3, rem = np & 7; const int cnt = base + (wid < rem ? 1 : 0), start = wid * base + (wid < rem ? wid : rem);
        const bf16_t* ap = A + (size_t)(r0 + fr) * K + start * 64 + 8 * fq; const bf16_t* bp = Bt + (size_t)(c0 + fr) * K + start * 64 + 8 * fq;
        f32x4 acc[4][4];
#pragma unroll
        for (int m = 0; m < 4; ++m)
#pragma unroll
            for (int n = 0; n < 4; ++n) acc[m][n] = (f32x4){0.f, 0.f, 0.f, 0.f};
        bf16x8 a[2][4], b[2][4];
#pragma unroll
        for (int hh = 0; hh < 2; ++hh)
#pragma unroll
            for (int m = 0; m < 4; ++m) { a[hh][m] = *(const bf16x8*)(ap + (size_t)16 * m * K + 32 * hh); b[hh][m] = *(const bf16x8*)(bp + (size_t)16 * m * K + 32 * hh); }
        for (int st = 0; st < cnt; ++st) { bf16x8 an[2][4], bn[2][4];
            const int nx = (st + 1 < cnt) ? st + 1 : st;
#pragma unroll
            for (int hh = 0; hh < 2; ++hh)
#pragma unroll
                for (int m = 0; m < 4; ++m) { an[hh][m] = *(const bf16x8*)(ap + (size_t)16 * m * K + 64 * nx + 32 * hh); bn[hh][m] = *(const bf16x8*)(bp + (size_t)16 * m * K + 64 * nx + 32 * hh); }
#pragma unroll
            for (int hh = 0; hh < 2; ++hh)
#pragma unroll
                for (int m = 0; m < 4; ++m)
#pragma unroll
                    for (int n = 0; n < 4; ++n) acc[m][n] = mfma16(b[hh][n], a[hh][m], acc[m][n]);
#pragma unroll
            for (int hh = 0; hh < 2; ++hh)
#pragma unroll
                for (int m = 0; m < 4; ++m) { a[hh][m] = an[hh][m]; b[hh][m] = bn[hh][m]; } }
#pragma unroll
        for (int m = 0; m < 4; ++m)
#pragma unroll
            for (int n = 0; n < 4; ++n) { const int row = 16 * m + fr; *(f32x4*)(RED + (size_t)(wid * 64 + row) * 64 + ((16 * n + 4 * fq + 4 * row) & 63)) = acc[m][n]; }
        __syncthreads();
        { const int rr = tid >> 3, cc = (tid & 7) * 8; f32x4 v0 = {0.f, 0.f, 0.f, 0.f}, v1 = {0.f, 0.f, 0.f, 0.f};
#pragma unroll
          for (int w = 0; w < 8; ++w) { v0 += *(const f32x4*)(RED + (size_t)(w * 64 + rr) * 64 + ((cc + 4 * rr) & 63)); v1 += *(const f32x4*)(RED + (size_t)(w * 64 + rr) * 64 + ((cc + 4 + 4 * rr) & 63)); }
          const int row = r0 + rr, col = c0 + cc;
          if (E.mode == 0) { const u32x4 xw = *(const u32x4*)(E.xin + (size_t)row * 1024 + col);
              const f32x4 a0 = {__uint_as_float(xw.x << 16), __uint_as_float(xw.x & 0xffff0000u), __uint_as_float(xw.y << 16), __uint_as_float(xw.y & 0xffff0000u)};
              const f32x4 a1 = {__uint_as_float(xw.z << 16), __uint_as_float(xw.z & 0xffff0000u), __uint_as_float(xw.w << 16), __uint_as_float(xw.w & 0xffff0000u)};
              v0 = a0 + v0 * E.alpha; v1 = a1 + v1 * E.alpha;
              if (E.xout) { *(f32x4*)(E.xout + (size_t)row * 1024 + col) = v0; *(f32x4*)(E.xout + (size_t)row * 1024 + col + 4) = v1; }
              if (E.xb) { u32x4 w; w.x = cvt_pk_bf16(v0[0], v0[1]); w.y = cvt_pk_bf16(v0[2], v0[3]); w.z = cvt_pk_bf16(v1[0], v1[1]); w.w = cvt_pk_bf16(v1[2], v1[3]); *(u32x4*)(E.xb + (size_t)row * 1024 + col) = w; }
              float sq = (v0[0] * v0[0] + v0[1] * v0[1]) + (v0[2] * v0[2] + v0[3] * v0[3]) + (v1[0] * v1[0] + v1[1] * v1[1]) + (v1[2] * v1[2] + v1[3] * v1[3]);
              sq += __shfl_xor(sq, 1); sq += __shfl_xor(sq, 2); sq += __shfl_xor(sq, 4);
              if ((tid & 7) == 0) unsafeAtomicAdd(E.ss + row, sq); }
          else { const float rs = pg8::rstd_of(E.ssin[row]) * E.mul; v0 = v0 * rs; v1 = v1 * rs;
              u32x4 w; w.x = cvt_pk_bf16(v0[0], v0[1]); w.y = cvt_pk_bf16(v0[2], v0[3]); w.z = cvt_pk_bf16(v1[0], v1[1]); w.w = cvt_pk_bf16(v1[2], v1[3]); *(u32x4*)(E.O + (size_t)row * 1024 + col) = w; } }
        __syncthreads();
    }
}
#ifndef PHMASK
#define PHMASK 0xffff
#endif
#define SS1 ((float*)(ws + WS_SS))
#define SS2 (SS1 + MT)
#define SS3 (SS1 + 2 * MT)
#define SS4 (SS1 + 3 * MT)
#define SS0 ((float*)(ws + WS_SS0))
#define SSM ((float*)(ws + WS_SSM))
#define W1GU ((bf16_t*)(ws + WS_W1GU))
#define W1D ((bf16_t*)(ws + WS_W1D))
#define W2GU ((bf16_t*)(ws + WS_W2GU))
#define W2D ((bf16_t*)(ws + WS_W2D))
#define WIN ((bf16_t*)(ws + WS_WIN))
#define WOUT ((bf16_t*)(ws + WS_WOUT))
#define WQ ((bf16_t*)(ws + WS_WQ))
#define WKV ((bf16_t*)(ws + WS_WKV))
#define WO ((bf16_t*)(ws + WS_WO))
#define WAT ((bf16_t*)(ws + WS_WAT))
#define WXT ((bf16_t*)(ws + WS_WXT))
#define PWT ((bf16_t*)(ws + WS_PWT))
#define XB ((bf16_t*)(ws + WS_XB))
#define X ((float*)(ws + WS_X))
#define H ((bf16_t*)(ws + WS_H))
#define PROJ ((bf16_t*)(ws + WS_PROJ))
#define MEMB ((bf16_t*)(ws + WS_MEMB))
#define KB ((bf16_t*)(ws + WS_KB))
#define VT ((bf16_t*)(ws + WS_VT))
#define Yb ((bf16_t*)(ws + WS_Y))
#define Qb ((bf16_t*)(ws + WS_Q))
#define Ob ((bf16_t*)(ws + WS_O))
#define HSL ((bf16_t*)(ws + WS_HSL))
#define PPb ((bf16_t*)(ws + WS_PP))
#define SUMH ((float*)(ws + WS_SUMH))
#define SUMP ((float*)(ws + WS_SUMP))

typedef const __attribute__((address_space(4))) Args CArgs0;
__global__ void __launch_bounds__(NTHR, 2) fwd_megakernel(Args args) {
    __shared__ __attribute__((aligned(16))) unsigned char lds_raw[136 * 1024];
    cg::grid_group grid = cg::this_grid();
    { volatile LAS unsigned* st0 = (volatile LAS unsigned*)((LAS unsigned char*)lds_raw + 139248); if (threadIdx.x < 4) st0[threadIdx.x] = 0u; }
    __syncthreads();
    unsigned char* A0_ws = ((CArgs0*)__builtin_amdgcn_kernarg_segment_ptr())->ws;
    XcdBarrier xbar = xcd_barrier_post((unsigned*)(A0_ws + WS_BAR), (volatile LAS unsigned*)((LAS unsigned char*)lds_raw + 139248));
    PG8_LAS unsigned char* ldsL = (PG8_LAS unsigned char*)lds_raw;
    unsigned char* lds = lds_raw;
    const int G = gridDim.x, cu = blockIdx.x; (void)args;
    typedef const __attribute__((address_space(4))) Args CArgs;
    CArgs* ap0 = (CArgs*)__builtin_amdgcn_kernarg_segment_ptr();
#define PHASE_ARGS CArgs* A_ = ap0; asm volatile("" : "+s"(A_)); const float* const __attribute__((address_space(4)))* in = A_->in; unsigned char* ws = A_->ws; float* out = A_->out; (void)in; (void)ws; (void)out; int tid_ = threadIdx.x; asm volatile("" : "+v"(tid_)); const int tid = tid_, lane = tid_ & 63, wid = __builtin_amdgcn_readfirstlane(tid_ >> 6); (void)tid; (void)lane; (void)wid;

#if (PHMASK >> 0) & 1
    { PHASE_ARGS
    {
        float* scr = (float*)(lds + wid * 16640);
        const int gw = cu * NWAVES + wid, NGW = G * NWAVES;
        constexpr int I_GU = 16 * 44, I_D = 44 * 16, I_IN = 16 * 24, I_SQ = 16 * 16, I_HD = 1, I_PG = 4;
        constexpr int NITEMS = 2 * (2 * I_GU + I_D) + I_IN + 5 * I_SQ + 2 * 8 * I_HD + 4 * I_PG;
        for (int it = gw; it < NITEMS; it += NGW) {
            int r = it;
            if (r < I_GU) { tr_item(in[9], DM, FF, in[8], W1GU, 128, 256, 0, scr, r, lane); continue; } r -= I_GU;
            if (r < I_GU) { tr_item(in[10], DM, FF, in[8], W1GU, 128, 256, 128, scr, r, lane); continue; } r -= I_GU;
            if (r < I_D) { tr_item(in[11], FF, DM, nullptr, W1D, DM, 0, 0, scr, r, lane); continue; } r -= I_D;
            if (r < I_GU) { tr_item(in[31], DM, FF, in[30], W2GU, 128, 256, 0, scr, r, lane); continue; } r -= I_GU;
            if (r < I_GU) { tr_item(in[32], DM, FF, in[30], W2GU, 128, 256, 128, scr, r, lane); continue; } r -= I_GU;
            if (r < I_D) { tr_item(in[33], FF, DM, nullptr, W2D, DM, 0, 0, scr, r, lane); continue; } r -= I_D;
            if (r < I_IN) { tr_item(in[13], DM, NIN, in[12], WIN, NIN, 0, 0, scr, r, lane); continue; } r -= I_IN;
            if (r < I_SQ) { tr_item(in[23], DM, DM, nullptr, WOUT, DM, 0, 0, scr, r, lane); continue; } r -= I_SQ;
            if (r < I_SQ) { tr_item(in[26], DM, DM, in[24], WQ, DM, 0, 0, scr, r, lane); continue; } r -= I_SQ;
            if (r < I_SQ) { tr_item(in[27], DM, DM, in[25], WKV, DM, 0, 0, scr, r, lane); continue; } r -= I_SQ;
            if (r < I_SQ) { tr_item(in[28], DM, DM, in[25], WKV, DM, 0, 1024, scr, r, lane); continue; } r -= I_SQ;
            if (r < I_SQ) { tr_item(in[29], DM, DM, nullptr, WO, DM, 0, 0, scr, r, lane); continue; } r -= I_SQ;
            if (r < 8 * I_HD) { const int g = r / I_HD; tr_item(in[16] + g * 4096, 64, 64, nullptr, WAT + g * 4096, 64, 0, 0, scr, r % I_HD, lane); continue; } r -= 8 * I_HD;
            if (r < 8 * I_HD) { const int g = r / I_HD; tr_item(in[18] + g * 4096, 64, 64, nullptr, WXT + g * 4096, 64, 0, 0, scr, r % I_HD, lane); continue; } r -= 8 * I_HD;
            { const int g = r / I_PG; tr_item(in[21] + g * 16384, 128, 128, nullptr, PWT + g * 16384, 128, 0, 0, scr, r % I_PG, lane); }
        }
        for (int m2 = gw; m2 < (MT + 2048) / 2; m2 += NGW) {
            const int m = 2 * m2; const float* src; bf16_t* dst; float* sso;
            if (m < MP) { src = in[0] + (size_t)m * DM; dst = XB + (size_t)m * DM; sso = SS0 + m; }
            else if (m < MT) { src = in[1] + (size_t)(m - MP) * DM; dst = XB + (size_t)m * DM; sso = SS0 + m; }
            else { src = in[2] + (size_t)(m - MT) * DM; dst = MEMB + (size_t)(m - MT) * DM; sso = SSM + (m - MT); }
            const f32x4* xr = (const f32x4*)src + lane; f32x4 v[8]; float s0 = 0.f, s1 = 0.f;
#pragma unroll
            for (int j = 0; j < 8; ++j) v[j] = xr[64 * j];
#pragma unroll
            for (int j = 0; j < 4; ++j) { s0 += (v[j][0] * v[j][0] + v[j][1] * v[j][1]) + (v[j][2] * v[j][2] + v[j][3] * v[j][3]); s1 += (v[4 + j][0] * v[4 + j][0] + v[4 + j][1] * v[4 + j][1]) + (v[4 + j][2] * v[4 + j][2] + v[4 + j][3] * v[4 + j][3]); }
            s0 = wave_sum(s0); s1 = wave_sum(s1);
            u32x2* o8 = (u32x2*)dst + lane;
#pragma unroll
            for (int j = 0; j < 8; ++j) { u32x2 w; w.x = cvt_pk_bf16(v[j][0], v[j][1]); w.y = cvt_pk_bf16(v[j][2], v[j][3]); o8[64 * j] = w; }
            if (lane == 0) { sso[0] = s0; sso[1] = s1; }
        }
    }
    }
#endif
    if (__builtin_expect(A0_ws == nullptr, 0)) grid.sync();
    xcd_barrier(xbar);
#if (PHMASK >> 1) & 1
    { PHASE_ARGS
    { pg8::Gemm g{XB, W1GU, MT, NGU, DM}; pg8::StaticOrder S; S.init(MT, NGU, G, cu); pg8::EpiSwiGLU E{H, SS0, FF};
      pg8::gemm_phase<pg8::EpiSwiGLU, pg8::StaticOrder, true, true>(ldsL, g, S, E); }
    }
#endif
    xcd_barrier(xbar);
#if (PHMASK >> 2) & 1
    { PHASE_ARGS
    { pg8::Gemm g{H, W1D, MP, DM, FF}; pg8::StaticOrder S; S.init(MP, DM, G, cu); pg8::EpiResid E{XB, nullptr, XB, SS1, 0.5f};
      pg8::gemm_phase<pg8::EpiResid, pg8::StaticOrder, true, true>(ldsL, g, S, E);
      SmallEpi se{0, XB + (size_t)MP * DM, nullptr, XB + (size_t)MP * DM, SS1 + MP, 0.5f, nullptr, nullptr, 0.f};
      small_gemm(lds, H + (size_t)MP * FF, W1D, FF, se, wid, lane); }
    }
#endif
    xcd_barrier(xbar);
#if (PHMASK >> 3) & 1
    { PHASE_ARGS
    { pg8::Gemm g{XB, WIN, MT, NIN, DM}; pg8::StaticOrder S; S.init(MT, NIN, G, cu); pg8::EpiScaleBf16 E{PROJ, NIN, SS1, 1.0f};
      pg8::gemm_phase<pg8::EpiScaleBf16, pg8::StaticOrder, true, true>(ldsL, g, S, E); }
    { pg8::Gemm g{MEMB, WKV, 2048, 2048, DM}; pg8::StaticOrder S; S.init(2048, 2048, G, (cu + G - 152) % G); pg8::EpiKV E{out + OUT_PMK, out + OUT_PMV, KB, SSM};
      pg8::gemm_phase<pg8::EpiKV, pg8::StaticOrder, true, true>(ldsL, g, S, E); }
    { pg8::Gemm g{WKV + (size_t)1024 * DM, MEMB, 1024, 2048, DM}; pg8::StaticOrder S; S.init(1024, 2048, G, (cu + G - 216) % G); pg8::EpiVT E{VT, SSM};
      pg8::gemm_phase<pg8::EpiVT, pg8::StaticOrder, true, true>(ldsL, g, S, E); }
    }
#endif
    xcd_barrier(xbar);
#define MIXP_INIT {PROJ, in[14], in[15], in[17], in[19], in[20], in[3], in[4], in[5], in[22], WAT, WXT, PWT, HSL, PPb, Yb, SUMH, SUMP, \
            out + OUT_PCONV, out + OUT_PLRU, out + OUT_PPOOL, out + OUT_SCONV, out + OUT_SLRU, out + OUT_SPOOL}
#if (PHMASK >> 4) & 1
    { PHASE_ARGS
    { MixP mp MIXP_INIT; mixer1(mp, lds, wid, lane); }
    }
#endif
    xcd_barrier(xbar);
#if (PHMASK >> 5) & 1
    { PHASE_ARGS
    { MixP mp MIXP_INIT; mixer2(mp, lds, wid, lane); }
    }
#endif
    xcd_barrier(xbar);
#if (PHMASK >> 6) & 1
    { PHASE_ARGS
    { pg8::Gemm g{Yb, WOUT, MP, DM, DM}; pg8::StaticOrder S; S.init(MP, DM, G, cu); pg8::EpiResid E{XB, nullptr, XB, SS2, 1.0f};
      pg8::gemm_phase<pg8::EpiResid, pg8::StaticOrder, true, true>(ldsL, g, S, E);
      SmallEpi se{0, XB + (size_t)MP * DM, nullptr, XB + (size_t)MP * DM, SS2 + MP, 1.0f, nullptr, nullptr, 0.f};
      small_gemm(lds, Yb + (size_t)MP * DM, WOUT, DM, se, wid, lane); }
    }
#endif
    xcd_barrier(xbar);
#if (PHMASK >> 7) & 1
    { PHASE_ARGS
    { pg8::Gemm g{XB, WQ, MP, DM, DM}; pg8::StaticOrder S; S.init(MP, DM, G, cu); pg8::EpiScaleBf16 E{Qb, DM, SS2, 0.0625f * 1.4426950408889634f};
      pg8::gemm_phase<pg8::EpiScaleBf16, pg8::StaticOrder, true, true>(ldsL, g, S, E);
      SmallEpi se{1, nullptr, nullptr, nullptr, nullptr, 0.f, Qb + (size_t)MP * DM, SS2 + MP, 0.0625f * 1.4426950408889634f};
      small_gemm(lds, XB + (size_t)MP * DM, WQ, DM, se, wid, lane); }
    }
#endif
    xcd_barrier(xbar);
#if (PHMASK >> 8) & 1
    { PHASE_ARGS
    { AttP ap{Qb, KB, VT, Ob, in[6], in[7]};
#pragma unroll 1
      for (int st = 0; st < 2; ++st) {
#ifndef NO_ATT_P
        if ((st ^ (cu & 1)) == 0) attn_prompt(ap, lds, wid, lane);
#endif
#ifndef NO_ATT_S
        if ((st ^ (cu & 1)) != 0) attn_sample(ap, lds, wid, lane);
#endif
      } }
    }
#endif
    xcd_barrier(xbar);
#if (PHMASK >> 9) & 1
    { PHASE_ARGS
    { pg8::Gemm g{Ob, WO, MP, DM, DM}; pg8::StaticOrder S; S.init(MP, DM, G, cu); pg8::EpiResid E{XB, nullptr, XB, SS3, 1.0f};
      pg8::gemm_phase<pg8::EpiResid, pg8::StaticOrder, true, true>(ldsL, g, S, E);
      SmallEpi se{0, XB + (size_t)MP * DM, nullptr, XB + (size_t)MP * DM, SS3 + MP, 1.0f, nullptr, nullptr, 0.f};
      small_gemm(lds, Ob + (size_t)MP * DM, WO, DM, se, wid, lane); }
    }
#endif
    xcd_barrier(xbar);
#if (PHMASK >> 10) & 1
    { PHASE_ARGS
    { pg8::Gemm g{XB, W2GU, MT, NGU, DM}; pg8::StaticOrder S; S.init(MT, NGU, G, cu); pg8::EpiSwiGLU E{H, SS3, FF};
      pg8::gemm_phase<pg8::EpiSwiGLU, pg8::StaticOrder, true, true>(ldsL, g, S, E); }
    }
#endif
    xcd_barrier(xbar);
#if (PHMASK >> 11) & 1
    { PHASE_ARGS
    { pg8::Gemm g{H, W2D, MP, DM, FF}; pg8::StaticOrder S; S.init(MP, DM, G, cu); pg8::EpiResid E{XB, out + OUT_Y, nullptr, SS4, 0.5f};
      pg8::gemm_phase<pg8::EpiResid, pg8::StaticOrder, true, true>(ldsL, g, S, E);
      SmallEpi se{0, XB + (size_t)MP * DM, out + OUT_Y + (size_t)MP * DM, nullptr, SS4 + MP, 0.5f, nullptr, nullptr, 0.f};
      small_gemm(lds, H + (size_t)MP * FF, W2D, FF, se, wid, lane); }
    }
#endif
    xcd_barrier(xbar);
#if (PHMASK >> 12) & 1
    { PHASE_ARGS
    { const int gw = cu * NWAVES + wid, NGW = G * NWAVES; const f32x4* gn = (const f32x4*)in[34] + lane;
      for (int m = gw; m < MT; m += NGW) { const float rs = pg8::rstd_of(SS4[m]); f32x4* xr = (f32x4*)(out + OUT_Y + (size_t)m * DM) + lane;
#pragma unroll
          for (int j = 0; j < 4; ++j) xr[64 * j] = xr[64 * j] * rs * gn[64 * j]; } }
    }
#endif
}

extern "C" void kernel_launch(void* const* d_in, const int* in_sizes, int n_in, void* d_out, int out_size, void* d_ws, size_t ws_size, hipStream_t stream) {
    static int grid = 0;
    if (grid == 0) {
        if (n_in != 35 || (size_t)out_size != OUT_TOTAL || ws_size < WS_END) { fprintf(stderr, "kernel_launch: unexpected shapes: n_in %d out %d ws %zu (need %zu)\n", n_in, out_size, ws_size, (size_t)WS_END); grid = -1; return; }
        int dev = 0, cus = 0, per = 0;
        hipGetDevice(&dev); hipDeviceGetAttribute(&cus, hipDeviceAttributeMultiprocessorCount, dev);
        hipOccupancyMaxActiveBlocksPerMultiprocessor(&per, fwd_megakernel, NTHR, 0);
        if (per < 1) { fprintf(stderr, "kernel_launch: occupancy query says %d blocks/CU\n", per); grid = -1; return; }
        grid = cus;
    }
    if (grid < 0) return;
    hipMemsetAsync((char*)d_ws + WS_BAR, 0, WS_SS + WS_SS_BYTES, stream);
    Args a{};
    for (int i = 0; i < 35; ++i) a.in[i] = (const float*)d_in[i];
    a.out = (float*)d_out; a.ws = (unsigned char*)d_ws;
    void* kargs[] = {&a};
    hipError_t e = hipLaunchCooperativeKernel((void*)fwd_megakernel, dim3(grid), dim3(NTHR), kargs, 0, stream);
    if (e != hipSuccess) fprintf(stderr, "kernel_launch: cooperative launch failed: %s (grid %d)\n", hipGetErrorString(e), grid);
}
```

```cpp
#include <hip/hip_runtime.h>
#include <hip/hip_cooperative_groups.h>
#include <cstdio>
#include <cstdint>
namespace cg = cooperative_groups;
namespace pg8 {
#define PG8_LAS __attribute__((address_space(3)))
typedef unsigned short bf16_t;
typedef short bf16x8 __attribute__((ext_vector_type(8)));
typedef float f32x4 __attribute__((ext_vector_type(4)));
typedef unsigned u32x4 __attribute__((ext_vector_type(4)));
constexpr int BM = 256, BK = 64, HALF = 128, HTB = HALF * BK * 2  , STAGE_BYTES = 8 * HTB, NXCD = 8, WGM = 8;

__host__ __device__ __forceinline__ int lds_byte(int r, int c) { const int st = (r >> 4) * 2 + (c >> 5), rr = r & 15, cc = c & 31, ob = rr * 64 + cc * 2; return st * 1024 + (ob ^ (((ob >> 9) & 1) << 5)); }
__host__ __device__ __forceinline__ void stage_rc(int b, int& R, int& C) { const int st = b / 1024, sb = b % 1024, swz = sb ^ (((sb >> 9) & 1) << 5); R = (st >> 1) * 16 + swz / 64; C = (st & 1) * 32 + (swz % 64) / 2; }
__host__ __device__ __forceinline__ int perm32(int rho) { const int n = rho >> 4, i = rho & 15; return 8 * (i >> 2) + 4 * n + (i & 3); }

struct Unit { int pm, pn; };
struct Gemm { const bf16_t* A; const bf16_t* Bt; int M, N, K; };

struct StaticOrder {
    int nM, nN, nwg, G, c;
    __host__ __device__ void init(int M, int N, int G_, int c_) { nM = M / BM; nN = N / BM; nwg = nM * nN; G = G_; c = c_; }
    __host__ __device__ bool next(int i, Unit& u) const {
        const long L = (long)i * G + c; if (L >= nwg) return false;
        int wgid = (int)L; { const int q = nwg / NXCD, r = nwg % NXCD, xcd = wgid % NXCD, off = wgid / NXCD; wgid = (xcd < r ? xcd * (q + 1) : r * (q + 1) + (xcd - r) * q) + off; }
        const int nig = WGM * nN, gid = wgid / nig, fm = gid * WGM, gsz = (nM - fm) < WGM ? (nM - fm) : WGM;
        u.pm = fm + ((wgid % nig) % gsz); u.pn = (wgid % nig) / gsz; return true;
    }
    __device__ __forceinline__ void a_ready(const Unit&) const {}
    __device__ __forceinline__ void done(const Unit&) const {}
};

__device__ __forceinline__ unsigned cvt_pk_bf16(float lo, float hi) { unsigned r; asm volatile("v_cvt_pk_bf16_f32 %0, %1, %2" : "=v"(r) : "v"(lo), "v"(hi)); return r; }
typedef float f32x2 __attribute__((ext_vector_type(2)));
__device__ __forceinline__ f32x2 gelu_pk(f32x2 v) {
    const f32x2 av = __builtin_elementwise_abs(v), d = av * 0.2316418882f + 1.0f;
    f32x2 t; t.x = __builtin_amdgcn_rcpf(d.x); t.y = __builtin_amdgcn_rcpf(d.y);
    f32x2 q = t * 0.5307027145f + (-0.7265760135f); q = q * t + 0.7107068705f; q = q * t + (-0.142248368f); q = q * t + 0.127414796f; q = q * t;
    const f32x2 s = (v * v) * (-0.72134752044f);
    f32x2 e; e.x = __builtin_amdgcn_exp2f(s.x); e.y = __builtin_amdgcn_exp2f(s.y);
    const f32x2 m = v * (q * e), r = v - m;
    f32x2 o; o.x = v.x < 0.f ? m.x : r.x; o.y = v.y < 0.f ? m.y : r.y; return o;
}

constexpr int MP_ROWS = 16384;
__device__ __forceinline__ float rstd_of(float ss) { return rsqrtf(ss * (1.0f / 1024.0f) + 1e-6f); }
__device__ __forceinline__ float fsigmoid(float x) { return __builtin_amdgcn_rcpf(1.0f + __expf(-x)); }
struct EpiSwiGLU {
    static constexpr bool PERM = true, AFTER_DRAIN = false;
    bf16_t* H; const float* ss; int ldh;
    __device__ __forceinline__ void operator()(const f32x4 (&acc)[2][2][4][2], const Unit& u, int wr, int wc, int fr, int fq) const {
#pragma unroll
        for (int ai = 0; ai < 2; ++ai)
#pragma unroll
            for (int m = 0; m < 4; ++m) { const int row = u.pm * BM + ai * HALF + wr * 64 + m * 16 + fr; const float rs = rstd_of(ss[row]);
                float hv[8];
#pragma unroll
                for (int n = 0; n < 2; ++n)
#pragma unroll
                    for (int i = 0; i < 4; ++i) { const float g = acc[ai][0][m][n][i] * rs, uu = acc[ai][1][m][n][i] * rs; hv[n * 4 + i] = g * uu * fsigmoid(g); }
                u32x4 w; w.x = cvt_pk_bf16(hv[0], hv[1]); w.y = cvt_pk_bf16(hv[2], hv[3]); w.z = cvt_pk_bf16(hv[4], hv[5]); w.w = cvt_pk_bf16(hv[6], hv[7]);
                *(u32x4*)(H + (size_t)row * ldh + u.pn * HALF + wc * 32 + 8 * fq) = w; }
    }
};
struct EpiResid {
    static constexpr bool PERM = true, AFTER_DRAIN = false;
    const bf16_t* xin; float* xout; bf16_t* xb; float* ss; float alpha;
    __device__ __forceinline__ void operator()(const f32x4 (&acc)[2][2][4][2], const Unit& u, int wr, int wc, int fr, int fq) const {
#pragma unroll
        for (int ai = 0; ai < 2; ++ai)
#pragma unroll
            for (int m = 0; m < 4; ++m) { const int row = u.pm * BM + ai * HALF + wr * 64 + m * 16 + fr;
                float sq = 0.f;
#pragma unroll
                for (int bj = 0; bj < 2; ++bj) { const int col = u.pn * BM + bj * HALF + wc * 32 + 8 * fq;
                    const u32x4 xw = *(const u32x4*)(xin + (size_t)row * 1024 + col);
                    const f32x4 a0 = {__uint_as_float(xw.x << 16), __uint_as_float(xw.x & 0xffff0000u), __uint_as_float(xw.y << 16), __uint_as_float(xw.y & 0xffff0000u)};
                    const f32x4 a1 = {__uint_as_float(xw.z << 16), __uint_as_float(xw.z & 0xffff0000u), __uint_as_float(xw.w << 16), __uint_as_float(xw.w & 0xffff0000u)};
                    const f32x4 v0 = a0 + acc[ai][bj][m][0] * alpha, v1 = a1 + acc[ai][bj][m][1] * alpha;
                    if (xout) { *(f32x4*)(xout + (size_t)row * 1024 + col) = v0; *(f32x4*)(xout + (size_t)row * 1024 + col + 4) = v1; }
                    if (xb) { u32x4 w; w.x = cvt_pk_bf16(v0[0], v0[1]); w.y = cvt_pk_bf16(v0[2], v0[3]); w.z = cvt_pk_bf16(v1[0], v1[1]); w.w = cvt_pk_bf16(v1[2], v1[3]);
                        *(u32x4*)(xb + (size_t)row * 1024 + col) = w; }
                    sq += (v0[0] * v0[0] + v0[1] * v0[1]) + (v0[2] * v0[2] + v0[3] * v0[3]) + (v1[0] * v1[0] + v1[1] * v1[1]) + (v1[2] * v1[2] + v1[3] * v1[3]); }
                sq += __shfl_xor(sq, 16); sq += __shfl_xor(sq, 32);
                if (fq == 0) unsafeAtomicAdd(ss + row, sq); }
    }
};
struct EpiScaleBf16 {
    static constexpr bool PERM = true, AFTER_DRAIN = false;
    bf16_t* O; int ldc; const float* ss; float mul;
    __device__ __forceinline__ void operator()(const f32x4 (&acc)[2][2][4][2], const Unit& u, int wr, int wc, int fr, int fq) const {
#pragma unroll
        for (int ai = 0; ai < 2; ++ai)
#pragma unroll
            for (int m = 0; m < 4; ++m) { const int row = u.pm * BM + ai * HALF + wr * 64 + m * 16 + fr; const float rs = rstd_of(ss[row]) * mul;
#pragma unroll
                for (int bj = 0; bj < 2; ++bj) { const int col = u.pn * BM + bj * HALF + wc * 32 + 8 * fq;
                    const f32x4 v0 = acc[ai][bj][m][0] * rs, v1 = acc[ai][bj][m][1] * rs;
                    u32x4 w; w.x = cvt_pk_bf16(v0[0], v0[1]); w.y = cvt_pk_bf16(v0[2], v0[3]); w.z = cvt_pk_bf16(v1[0], v1[1]); w.w = cvt_pk_bf16(v1[2], v1[3]);
                    *(u32x4*)(O + (size_t)row * ldc + col) = w; } }
    }
};
struct EpiKV {
    static constexpr bool PERM = true, AFTER_DRAIN = false;
    float* outK; float* outV; bf16_t* KB; const float* ss;
    __device__ __forceinline__ void operator()(const f32x4 (&acc)[2][2][4][2], const Unit& u, int wr, int wc, int fr, int fq) const {
#pragma unroll
        for (int ai = 0; ai < 2; ++ai)
#pragma unroll
            for (int m = 0; m < 4; ++m) { const int row = u.pm * BM + ai * HALF + wr * 64 + m * 16 + fr; const float rs = rstd_of(ss[row]);
#pragma unroll
                for (int bj = 0; bj < 2; ++bj) { const int col = u.pn * BM + bj * HALF + wc * 32 + 8 * fq;
                    const f32x4 v0 = acc[ai][bj][m][0] * rs, v1 = acc[ai][bj][m][1] * rs;
                    if (col < 1024) { *(f32x4*)(outK + (size_t)row * 1024 + col) = v0; *(f32x4*)(outK + (size_t)row * 1024 + col + 4) = v1;
                        u32x4 w; w.x = cvt_pk_bf16(v0[0], v0[1]); w.y = cvt_pk_bf16(v0[2], v0[3]); w.z = cvt_pk_bf16(v1[0], v1[1]); w.w = cvt_pk_bf16(v1[2], v1[3]);
                        *(u32x4*)(KB + (size_t)row * 1024 + col) = w; }
                    else { *(f32x4*)(outV + (size_t)row * 1024 + col - 1024) = v0; *(f32x4*)(outV + (size_t)row * 1024 + col - 1024 + 4) = v1; } } }
    }
};
struct EpiVT {
    static constexpr bool PERM = true, AFTER_DRAIN = false;
    bf16_t* VT; const float* ss;
    __device__ __forceinline__ void operator()(const f32x4 (&acc)[2][2][4][2], const Unit& u, int wr, int wc, int fr, int fq) const {
#pragma unroll
        for (int bj = 0; bj < 2; ++bj) { const int col = u.pn * BM + bj * HALF + wc * 32 + 8 * fq;
            const f32x4 s0 = *(const f32x4*)(ss + col), s1 = *(const f32x4*)(ss + col + 4);
            f32x4 r0, r1;
#pragma unroll
            for (int i = 0; i < 4; ++i) { r0[i] = rstd_of(s0[i]); r1[i] = rstd_of(s1[i]); }
#pragma unroll
            for (int ai = 0; ai < 2; ++ai)
#pragma unroll
                for (int m = 0; m < 4; ++m) { const int row = u.pm * BM + ai * HALF + wr * 64 + m * 16 + fr;
                    const f32x4 v0 = acc[ai][bj][m][0] * r0, v1 = acc[ai][bj][m][1] * r1;
                    u32x4 w; w.x = cvt_pk_bf16(v0[0], v0[1]); w.y = cvt_pk_bf16(v0[2], v0[3]); w.z = cvt_pk_bf16(v1[0], v1[1]); w.w = cvt_pk_bf16(v1[2], v1[3]);
                    *(u32x4*)(VT + (size_t)row * 2048 + col) = w; } }
    }
};
template <class Epi, class Sched, bool ALIGN_EPI = false, bool SP2 = false>
__device__ __forceinline__ void gemm_phase(PG8_LAS unsigned char* lds, const Gemm g, const Sched& S, const Epi& E) {
    const int tid = threadIdx.x, wid = __builtin_amdgcn_readfirstlane(tid >> 6), lane = tid & 63, wr = wid >> 2, wc = wid & 3, fr = lane & 15, fq = lane >> 4;
    const int K = g.K, nt = K / BK;
    unsigned voffA[2], voffB[2];
#pragma unroll
    for (int i = 0; i < 2; ++i) { int R, C; stage_rc(tid * 16 + i * 8192, R, C); const int Rb = Epi::PERM ? ((R & ~31) + perm32(R & 31)) : R;
        voffA[i] = (unsigned)(R * K + C) * 2u; voffB[i] = (unsigned)(Rb * K + C) * 2u; }
    const size_t kstep = (size_t)(BK * 2);
    const size_t hstep = (size_t)HALF * K * 2;
    const size_t tstep = 2 * hstep;
    const unsigned ldsw = (unsigned)wid * 1024u;
    const int aoff = lds_byte(wr * 64 + fr, fq * 8), boff = lds_byte(wc * 32 + fr, fq * 8);
#define PG8_SA(b, h) (((b) * 2 + (h)) * HTB)
#define PG8_SB(b, h) ((4 + (b) * 2 + (h)) * HTB)
#define PG8_STAGE(bufoff, gbase, voff) do { _Pragma("unroll") for (int _i = 0; _i < 2; ++_i) \
        __builtin_amdgcn_global_load_lds((const unsigned*)((const char*)(gbase) + (voff)[_i]), (PG8_LAS unsigned*)(lds + (bufoff) + ldsw + _i * 8192), 16, 0, 0); } while (0)
#define PG8_LDA(dst, b, h) do { _Pragma("unroll") for (int m = 0; m < 4; ++m) _Pragma("unroll") for (int k = 0; k < 2; ++k) dst[m][k] = *(const PG8_LAS bf16x8*)(lds + PG8_SA(b, h) + aoff + m * 2048 + k * 1024); } while (0)
#define PG8_LDB(dst, b, h) do { _Pragma("unroll") for (int n = 0; n < 2; ++n) _Pragma("unroll") for (int k = 0; k < 2; ++k) dst[n][k] = *(const PG8_LAS bf16x8*)(lds + PG8_SB(b, h) + boff + n * 2048 + k * 1024); } while (0)
#define PG8_MMA(ai, bj, At, Bt) do { __builtin_amdgcn_s_setprio(1); _Pragma("unroll") for (int m = 0; m < 4; ++m) _Pragma("unroll") for (int n = 0; n < 2; ++n) _Pragma("unroll") for (int k = 0; k < 2; ++k) \
        acc[ai][bj][m][n] = __builtin_amdgcn_mfma_f32_16x16x32_bf16(Bt[n][k], At[m][k], acc[ai][bj][m][n], 0, 0, 0); __builtin_amdgcn_s_setprio(0); } while (0)
#define PG8_WAIT_V(n) asm volatile("s_waitcnt vmcnt(" #n ")" ::: "memory")
#define PG8_WAIT_L(n) asm volatile("s_waitcnt lgkmcnt(" #n ")" ::: "memory")
#define PG8_BAR __builtin_amdgcn_s_barrier()
#define PG8_SCHED __builtin_amdgcn_sched_barrier(0)
    Unit cur, nxt; int ui = 0;
    if (!S.next(0, cur)) return;
    f32x4 acc[2][2][4][2];
#pragma unroll
    for (int a = 0; a < 2; ++a)
#pragma unroll
        for (int b = 0; b < 2; ++b)
#pragma unroll
            for (int m = 0; m < 4; ++m)
#pragma unroll
                for (int n = 0; n < 2; ++n) acc[a][b][m][n] = (f32x4){0.f, 0.f, 0.f, 0.f};
    bf16x8 At[4][2], B0[2][2], B1[2][2];
    const char* cA = (const char*)g.A + (size_t)cur.pm * tstep; const char* cB = (const char*)g.Bt + (size_t)cur.pn * tstep;
    S.a_ready(cur);
    if constexpr (SP2) {
        PG8_STAGE(PG8_SB(0, 0), cB, voffB); PG8_STAGE(PG8_SB(0, 1), cB + hstep, voffB); PG8_STAGE(PG8_SA(0, 0), cA, voffA); PG8_STAGE(PG8_SA(0, 1), cA + hstep, voffA);
        if (wr == 1) PG8_BAR;
        PG8_WAIT_V(2); PG8_BAR;
        PG8_STAGE(PG8_SB(1, 0), cB + kstep, voffB); PG8_STAGE(PG8_SA(1, 0), cA + kstep, voffA); PG8_STAGE(PG8_SB(1, 1), cB + hstep + kstep, voffB);
        PG8_WAIT_V(6); PG8_BAR;
    } else {
        PG8_STAGE(PG8_SB(0, 0), cB, voffB); PG8_STAGE(PG8_SA(0, 0), cA, voffA); PG8_STAGE(PG8_SB(0, 1), cB + hstep, voffB); PG8_STAGE(PG8_SA(0, 1), cA + hstep, voffA);
        if (wr == 1) PG8_BAR;
        PG8_WAIT_V(4); PG8_BAR;
        PG8_STAGE(PG8_SB(1, 0), cB + kstep, voffB); PG8_STAGE(PG8_SA(1, 0), cA + kstep, voffA); PG8_STAGE(PG8_SB(1, 1), cB + hstep + kstep, voffB);
        PG8_WAIT_V(6); PG8_BAR;
    }
    for (;;) {
        const bool has_next = S.next(ui + 1, nxt);
        const char* nA = has_next ? (const char*)g.A + (size_t)nxt.pm * tstep : cA; const char* nB = has_next ? (const char*)g.Bt + (size_t)nxt.pn * tstep : cB;
        for (int t = 0; t < nt; t += 2) {
            const bool last = (t == nt - 2);
            const char* a1 = cA + (size_t)(t + 1) * kstep;
            const char* a2 = last ? nA : cA + (size_t)(t + 2) * kstep; const char* b2 = last ? nB : cB + (size_t)(t + 2) * kstep;
            const char* a3 = a2 + kstep; const char* b3 = b2 + kstep;
            if (last && has_next) S.a_ready(nxt);
            if constexpr (SP2) {
            PG8_LDB(B0, 0, 0); PG8_LDB(B1, 0, 1); PG8_SCHED; PG8_LDA(At, 0, 0); PG8_STAGE(PG8_SA(1, 1), a1 + hstep, voffA);
            PG8_WAIT_V(8); PG8_WAIT_L(0); PG8_BAR; PG8_MMA(0, 0, At, B0); PG8_MMA(0, 1, At, B1); PG8_BAR; PG8_SCHED;
            PG8_LDA(At, 0, 1); PG8_STAGE(PG8_SB(0, 0), b2, voffB); PG8_STAGE(PG8_SB(0, 1), b2 + hstep, voffB); PG8_STAGE(PG8_SA(0, 0), a2, voffA);
            PG8_WAIT_V(8); PG8_WAIT_L(0); PG8_BAR; PG8_MMA(1, 0, At, B0); PG8_MMA(1, 1, At, B1); PG8_BAR; PG8_SCHED;
            PG8_LDB(B0, 1, 0); PG8_LDB(B1, 1, 1); PG8_SCHED; PG8_LDA(At, 1, 0); PG8_STAGE(PG8_SA(0, 1), a2 + hstep, voffA);
            PG8_WAIT_V(8); PG8_WAIT_L(0); PG8_BAR; PG8_MMA(0, 0, At, B0); PG8_MMA(0, 1, At, B1); PG8_BAR; PG8_SCHED;
            PG8_LDA(At, 1, 1); PG8_STAGE(PG8_SB(1, 0), b3, voffB); PG8_STAGE(PG8_SB(1, 1), b3 + hstep, voffB); PG8_STAGE(PG8_SA(1, 0), a3, voffA);
            PG8_WAIT_V(8); PG8_WAIT_L(0); PG8_BAR; PG8_MMA(1, 0, At, B0); PG8_MMA(1, 1, At, B1); PG8_BAR; PG8_SCHED;
            } else {
            PG8_LDB(B0, 0, 0); PG8_SCHED; PG8_LDA(At, 0, 0); PG8_STAGE(PG8_SA(1, 1), a1 + hstep, voffA);
            PG8_WAIT_L(8); PG8_BAR; PG8_WAIT_L(0); PG8_MMA(0, 0, At, B0); PG8_BAR; PG8_SCHED;
            PG8_LDB(B1, 0, 1); PG8_STAGE(PG8_SB(0, 0), b2, voffB);
            PG8_BAR; PG8_WAIT_L(0); PG8_MMA(0, 1, At, B1); PG8_BAR;
            PG8_LDA(At, 0, 1); PG8_STAGE(PG8_SA(0, 0), a2, voffA);
            PG8_BAR; PG8_WAIT_L(0); PG8_MMA(1, 0, At, B0); PG8_BAR; PG8_SCHED;
            PG8_STAGE(PG8_SB(0, 1), b2 + hstep, voffB);
            PG8_WAIT_V(6); PG8_BAR; PG8_MMA(1, 1, At, B1); PG8_BAR;
            PG8_LDB(B0, 1, 0); PG8_SCHED; PG8_LDA(At, 1, 0); PG8_STAGE(PG8_SA(0, 1), a2 + hstep, voffA);
            PG8_WAIT_L(8); PG8_BAR; PG8_WAIT_L(0); PG8_MMA(0, 0, At, B0); PG8_BAR; PG8_SCHED;
            PG8_LDB(B1, 1, 1); PG8_STAGE(PG8_SB(1, 0), b3, voffB);
            PG8_BAR; PG8_WAIT_L(0); PG8_MMA(0, 1, At, B1); PG8_BAR;
            PG8_LDA(At, 1, 1); PG8_STAGE(PG8_SA(1, 0), a3, voffA);
            PG8_BAR; PG8_WAIT_L(0); PG8_MMA(1, 0, At, B0); PG8_BAR; PG8_SCHED;
            PG8_STAGE(PG8_SB(1, 1), b3 + hstep, voffB);
            PG8_WAIT_V(6); PG8_BAR; PG8_MMA(1, 1, At, B1); PG8_BAR;
            }
        }
        if constexpr (ALIGN_EPI) { if (wr == 0) PG8_BAR; }
        if constexpr (!Epi::AFTER_DRAIN) { E(acc, cur, wr, wc, fr, fq); S.done(cur); }
        if (!has_next) break;
#pragma unroll
        for (int a = 0; a < 2; ++a)
#pragma unroll
            for (int b = 0; b < 2; ++b)
#pragma unroll
                for (int m = 0; m < 4; ++m)
#pragma unroll
                    for (int n = 0; n < 2; ++n) acc[a][b][m][n] = (f32x4){0.f, 0.f, 0.f, 0.f};
        cur = nxt; cA = nA; cB = nB; ++ui;
        if constexpr (ALIGN_EPI) { if (wr == 1) PG8_BAR; }
    }
    PG8_WAIT_V(0);
    if constexpr (!ALIGN_EPI) { if (wr == 0) PG8_BAR; }
    PG8_BAR;
    if constexpr (Epi::AFTER_DRAIN) { E.fused(acc, cur, wr, wc, fr, fq, lds, wid, lane); S.done(cur); }
#undef PG8_SA
#undef PG8_SB
#undef PG8_STAGE
#undef PG8_LDA
#undef PG8_LDB
#undef PG8_MMA
#undef PG8_WAIT_V
#undef PG8_WAIT_L
#undef PG8_BAR
#undef PG8_SCHED
}
}
using pg8::fsigmoid; using pg8::bf16_t; using pg8::bf16x8; using pg8::f32x4; using pg8::u32x4; using pg8::cvt_pk_bf16;
typedef unsigned u32x2 __attribute__((ext_vector_type(2)));
constexpr int MP = 16384, MS = 1024, MT = 17408, DM = 1024, FF = 2816, NGU = 5632, NIN = 1536;
constexpr int NTHR = 512, NWAVES = 8;
constexpr size_t OUT_Y = 0, OUT_PCONV = 17825792, OUT_PLRU = 17838080, OUT_PPOOL = 17842176, OUT_PMK = 17903616, OUT_PMV = 20000768,
                 OUT_SCONV = 22097920, OUT_SLRU = 22294528, OUT_SPOOL = 22360064, OUT_TOTAL = 23343104;
constexpr size_t al256(size_t x) { return (x + 255) & ~(size_t)255; }
constexpr size_t WS_BAR = 0;
constexpr size_t WS_SS = 16384;
constexpr size_t WS_SS_BYTES = 4 * (size_t)MT * 4;
constexpr size_t WS_SS0 = al256(WS_SS + WS_SS_BYTES);
constexpr size_t WS_SSM = al256(WS_SS0 + (size_t)MT * 4);
constexpr size_t WS_W1GU = al256(WS_SSM + 2048 * 4);
constexpr size_t WS_W1D = WS_W1GU + (size_t)NGU * DM * 2;
constexpr size_t WS_W2GU = WS_W1D + (size_t)DM * FF * 2;
constexpr size_t WS_W2D = WS_W2GU + (size_t)NGU * DM * 2;
constexpr size_t WS_WIN = WS_W2D + (size_t)DM * FF * 2;
constexpr size_t WS_WOUT = WS_WIN + (size_t)NIN * DM * 2;
constexpr size_t WS_WQ = WS_WOUT + (size_t)DM * DM * 2;
constexpr size_t WS_WKV = WS_WQ + (size_t)DM * DM * 2;
constexpr size_t WS_WO = WS_WKV + (size_t)2 * DM * DM * 2;
constexpr size_t WS_WAT = WS_WO + (size_t)DM * DM * 2;
constexpr size_t WS_WXT = WS_WAT + 8 * 64 * 64 * 2;
constexpr size_t WS_PWT = WS_WXT + 8 * 64 * 64 * 2;
constexpr size_t WS_XB = al256(WS_PWT + 4 * 128 * 128 * 2);
constexpr size_t WS_X = WS_XB + (size_t)MT * DM * 2;
constexpr size_t WS_H = WS_X + (size_t)MT * DM * 4;
constexpr size_t WS_PROJ = WS_H + (size_t)MT * FF * 2;
constexpr size_t WS_MEMB = WS_PROJ + (size_t)MT * NIN * 2;
constexpr size_t WS_KB = WS_MEMB + (size_t)2048 * DM * 2;
constexpr size_t WS_VT = WS_KB + (size_t)2048 * DM * 2;
constexpr size_t WS_Y = WS_VT + (size_t)2048 * DM * 2;
constexpr size_t WS_Q = WS_Y + (size_t)MT * DM * 2;
constexpr size_t WS_O = WS_Q + (size_t)MT * DM * 2;
constexpr size_t WS_HSL = WS_O + (size_t)MT * DM * 2;
constexpr size_t WS_PP = WS_HSL + (size_t)MT * 512 * 2;
constexpr size_t WS_SUMH = WS_PP + (size_t)MT * 512 * 2;
constexpr size_t WS_SUMP = WS_SUMH + (size_t)8 * 32 * 512 * 4;
constexpr size_t WS_END = WS_SUMP + (size_t)8 * 32 * 512 * 4;

#define LAS __attribute__((address_space(3)))
struct Args { const float* in[35]; float* out; unsigned char* ws; };

__device__ __forceinline__ float bf2f(bf16_t v) { return __uint_as_float((unsigned)v << 16); }
__device__ __forceinline__ bf16_t f2bf(float f) { unsigned u = __float_as_uint(f); u += 0x7fffu + ((u >> 16) & 1u); return (bf16_t)(u >> 16); }
__device__ __forceinline__ void wave_lds_sync() { asm volatile("s_waitcnt lgkmcnt(0)" ::: "memory"); }
__device__ __forceinline__ float wave_sum(float v) {
#pragma unroll
    for (int o = 1; o < 64; o <<= 1) v += __shfl_xor(v, o);
    return v;
}
__device__ __forceinline__ float wave_max(float v) {
#pragma unroll
    for (int o = 1; o < 64; o <<= 1) v = fmaxf(v, __shfl_xor(v, o));
    return v;
}
__device__ __forceinline__ f32x4 mfma16(bf16x8 a, bf16x8 b, f32x4 c) { return __builtin_amdgcn_mfma_f32_16x16x32_bf16(a, b, c, 0, 0, 0); }

__device__ __forceinline__ void tr_item(const float* W, int K, int N, const float* g, bf16_t* WT, int grp, int gmul, int goff, float* scr, int item, int lane) {
    const int nblk = N / 64, kb = item / nblk, nb = item % nblk, k0 = 64 * kb, n0 = 64 * nb; const int lr = lane >> 4, lc = (lane & 15) * 4;
    f32x4 v[16];
#pragma unroll
    for (int i = 0; i < 16; ++i) v[i] = *(const f32x4*)(W + (size_t)(k0 + 4 * i + lr) * N + n0 + lc);
#pragma unroll
    for (int i = 0; i < 16; ++i) { const int k = 4 * i + lr; const float gg = g ? g[k0 + k] : 1.0f; float* d = scr + k * 65 + lc; d[0] = v[i][0] * gg; d[1] = v[i][1] * gg; d[2] = v[i][2] * gg; d[3] = v[i][3] * gg; }
    wave_lds_sync();
    const int c = lane & 7;
#pragma unroll
    for (int j = 0; j < 8; ++j) { const int n = (lane >> 3) + 8 * j; const float* s = scr + (8 * c) * 65 + n; const int nn = n0 + n; const int dr = (nn / grp) * gmul + goff + nn % grp;
        u32x4 o; o.x = cvt_pk_bf16(s[0 * 65], s[1 * 65]); o.y = cvt_pk_bf16(s[2 * 65], s[3 * 65]); o.z = cvt_pk_bf16(s[4 * 65], s[5 * 65]); o.w = cvt_pk_bf16(s[6 * 65], s[7 * 65]);
        *(u32x4*)(WT + (size_t)dr * K + k0 + 8 * c) = o; }
    wave_lds_sync();
}
__device__ __forceinline__ void row_to_bf16(const float* xrow, bf16_t* orow, float* ssout, int lane) {
    const f32x4* xr = (const f32x4*)xrow + lane; f32x4 v[4]; float s = 0.f;
#pragma unroll
    for (int j = 0; j < 4; ++j) { v[j] = xr[64 * j]; s += (v[j][0] * v[j][0] + v[j][1] * v[j][1]) + (v[j][2] * v[j][2] + v[j][3] * v[j][3]); }
    s = wave_sum(s);
    u32x2* o8 = (u32x2*)orow + lane;
#pragma unroll
    for (int j = 0; j < 4; ++j) { u32x2 w; w.x = cvt_pk_bf16(v[j][0], v[j][1]); w.y = cvt_pk_bf16(v[j][2], v[j][3]); o8[64 * j] = w; }
    if (lane == 0) *ssout = s;
}
#define XB_TMO      128
#define XB_XCNT(j)  (256  + 64 * (j))
#define XB_XSUB(j)  (1280 + 64 * (j))
#define XB_XGEN(j)  (2304 + 64 * (j))
#define XB_TOP      3328
#define XB_TOPGEN   3392
#define XCD_BAR_WORDS 3456
#define XB_SPIN_CAP (1u << 18)

__device__ __forceinline__ unsigned xb_ld(unsigned* p)              { return __hip_atomic_load(p, __ATOMIC_RELAXED, __HIP_MEMORY_SCOPE_AGENT); }
__device__ __forceinline__ unsigned xb_add(unsigned* p, unsigned v) { return __hip_atomic_fetch_add(p, v, __ATOMIC_RELAXED, __HIP_MEMORY_SCOPE_AGENT); }
__device__ __forceinline__ unsigned xb_xcc_id() { return (unsigned)__builtin_amdgcn_s_getreg((3 << 11) | 20) & 0xFu; }
#define XB_SPIN(cond, bar) do { unsigned _sp = 0; while (cond) { __builtin_amdgcn_s_sleep(1); \
    if ((++_sp & 255u) == 0u) { if (xb_ld(&(bar)[XB_TMO])) break; if (_sp > XB_SPIN_CAP) { atomicAdd(&(bar)[XB_TMO], 1u); break; } } } } while (0)

struct XcdBarrier {
    unsigned* bar; unsigned x;
    volatile LAS unsigned* st;
};

__device__ __forceinline__ XcdBarrier xcd_barrier_post(unsigned* bar, volatile LAS unsigned* st) {
    XcdBarrier b; b.bar = bar; b.x = xb_xcc_id(); b.st = st;
    if (threadIdx.x == 0) (void)xb_add(&bar[XB_XCNT(b.x)], 1u);
    return b;
}
__device__ __forceinline__ void xcd_barrier_complete(unsigned* bar, unsigned x, unsigned& nloc, unsigned& nx) {
    const unsigned G = gridDim.x * gridDim.y * gridDim.z;
    unsigned sum, cnt, mine, sp = 0u;
    for (;;) {
        sum = 0u; cnt = 0u; mine = 0u;
#pragma unroll
        for (unsigned j = 0; j < 16; ++j) { const unsigned c = xb_ld(&bar[XB_XCNT(j)]); sum += c; cnt += (c > 0u) ? 1u : 0u; mine = (j == x) ? c : mine; }
        if (sum == G) break;
        __builtin_amdgcn_s_sleep(1);
        if ((++sp & 255u) == 0u) { if (xb_ld(&bar[XB_TMO])) break; if (sp > XB_SPIN_CAP) { atomicAdd(&bar[XB_TMO], 1u); break; } }
    }
    nloc = mine > 0u ? mine : 1u; nx = cnt > 0u ? cnt : 1u;
}

__device__ __forceinline__ void xcd_barrier(const XcdBarrier& b) {
    asm volatile("s_waitcnt vmcnt(0)" ::: "memory");
    __syncthreads();
    if (threadIdx.x == 0) {
        unsigned* bar = b.bar;
        __builtin_amdgcn_s_waitcnt(0);
        unsigned nloc = b.st[0], nx = b.st[1];
        if (nloc == 0u) { xcd_barrier_complete(bar, b.x, nloc, nx); b.st[0] = nloc; b.st[1] = nx; }
        const unsigned old = xb_add(&bar[XB_XSUB(b.x)], 1u);
        const unsigned gen = old / nloc;
        if (old + 1u == (gen + 1u) * nloc) {
            __builtin_amdgcn_fence(__ATOMIC_RELEASE, "agent");
            asm volatile("s_waitcnt vmcnt(0)" ::: "memory");
            const unsigned og = xb_add(&bar[XB_TOP], 1u);
            const unsigned tg = og / nx;
            if (og + 1u == (tg + 1u) * nx) xb_add(&bar[XB_TOPGEN], 1u);
            else XB_SPIN(xb_ld(&bar[XB_TOPGEN]) == tg, bar);
            __builtin_amdgcn_fence(__ATOMIC_ACQUIRE, "agent");
            xb_add(&bar[XB_XGEN(b.x)], 1u);
            asm volatile("s_waitcnt vmcnt(0)" ::: "memory");
        } else {
            XB_SPIN(xb_ld(&bar[XB_XGEN(b.x)]) == gen, bar);
            __builtin_amdgcn_fence(__ATOMIC_ACQUIRE, "agent");
            asm volatile("s_waitcnt vmcnt(0)" ::: "memory");
        }
    }
    __syncthreads();
}
struct MixP {
    const bf16_t* PROJ; const float *conv_w, *conv_b, *lru_ba, *lru_bx, *lru_lambda, *state_conv, *state_lru, *state_pool, *pool_scale;
    const bf16_t *WaT, *WxT, *PwT; bf16_t *HSL, *PP, *Y; float *SUMH, *SUMP; float *o_pconv, *o_plru, *o_ppool, *o_sconv, *o_slru, *o_spool;
};
__device__ __forceinline__ void mixer1(const MixP& p, unsigned char* lds, int wid, int lane) {
    unsigned char* wl = lds + wid * 12288;
    bf16_t* UC = (bf16_t*)wl; float* A2 = (float*)(wl + 2304); float* B2 = (float*)(wl + 2304 + 4352); float* TAB = (float*)(wl + 2304 + 8704);
    const int ch = wid * 64 + lane, fr = lane & 15, fq = lane >> 4;
    TAB[lane] = p.lru_ba[ch]; TAB[64 + lane] = p.lru_bx[ch]; TAB[128 + lane] = -8.0f * log1pf(expf(-p.lru_lambda[ch]));
    const float cw0 = p.conv_w[ch], cw1 = p.conv_w[512 + ch], cw2 = p.conv_w[1024 + ch], cw3 = p.conv_w[1536 + ch], cb = p.conv_b[ch];
    bf16x8 XA[4][2], XI[4][2];
#pragma unroll
    for (int n = 0; n < 4; ++n)
#pragma unroll
        for (int kk = 0; kk < 2; ++kk) { XA[n][kk] = *(const bf16x8*)(p.WaT + wid * 4096 + (16 * n + fr) * 64 + 8 * fq + 32 * kk); XI[n][kk] = *(const bf16x8*)(p.WxT + wid * 4096 + (16 * n + fr) * 64 + 8 * fq + 32 * kk); }
    wave_lds_sync();
    for (int unit = blockIdx.x; unit < 320; unit += gridDim.x) {
        const bool smp = unit >= 256; const int b = unit >> 5, c = unit & 31; const int sbase = (unit - 256) * 2;
        const int R0 = smp ? MP + (unit - 256) * 16 : b * 2048 + c * 64; const int nq = smp ? 1 : 4;
        float u1 = 0.f, u2 = 0.f, u3 = 0.f, h = 0.f, Pc = 1.0f;
        if (!smp && c > 0) { u1 = bf2f(p.PROJ[(size_t)(R0 - 1) * NIN + ch]); u2 = bf2f(p.PROJ[(size_t)(R0 - 2) * NIN + ch]); u3 = bf2f(p.PROJ[(size_t)(R0 - 3) * NIN + ch]); }
        for (int q4 = 0; q4 < nq; ++q4) {
#pragma unroll
            for (int i = 0; i < 16; ++i) { const int t = 16 * q4 + i; const int row = R0 + t;
                if (smp && (i & 7) == 0) { const float* sc = p.state_conv + (size_t)(sbase + (t >> 3)) * 1536 + ch; u3 = sc[0]; u2 = sc[512]; u1 = sc[1024]; }
                const float u = bf2f(p.PROJ[(size_t)row * NIN + ch]);
                const float uc = cb + cw3 * u + cw2 * u1 + cw1 * u2 + cw0 * u3; u3 = u2; u2 = u1; u1 = u;
                UC[i * 72 + lane] = f2bf(uc);
                if (smp) { if ((i & 7) >= 5) p.o_sconv[((size_t)(sbase + (t >> 3)) * 3 + ((i & 7) - 5)) * 512 + ch] = u; }
                else if (c == 31 && t >= 61) p.o_pconv[((size_t)b * 3 + (t - 61)) * 512 + ch] = u;
            }
            wave_lds_sync();
            const bf16x8 Y0 = *(const bf16x8*)(UC + fr * 72 + 8 * fq), Y1 = *(const bf16x8*)(UC + fr * 72 + 8 * fq + 32);
#pragma unroll
            for (int n = 0; n < 4; ++n) { f32x4 aR = {0.f, 0.f, 0.f, 0.f}, aI = {0.f, 0.f, 0.f, 0.f};
                aR = mfma16(XA[n][0], Y0, aR); aR = mfma16(XA[n][1], Y1, aR); aI = mfma16(XI[n][0], Y0, aI); aI = mfma16(XI[n][1], Y1, aI);
                const int j0 = 16 * n + 4 * fq; const f32x4 ba4 = *(const f32x4*)(TAB + j0), bx4 = *(const f32x4*)(TAB + 64 + j0), sp4 = *(const f32x4*)(TAB + 128 + j0);
                const u32x2 ucw = *(const u32x2*)(UC + fr * 72 + j0);
                const float ucv[4] = {__uint_as_float(ucw.x << 16), __uint_as_float(ucw.x & 0xffff0000u), __uint_as_float(ucw.y << 16), __uint_as_float(ucw.y & 0xffff0000u)};
                f32x4 a4, b4;
#pragma unroll
                for (int i = 0; i < 4; ++i) { const float r = fsigmoid(aR[i] + ba4[i]), ig = fsigmoid(aI[i] + bx4[i]); const float a = __expf(sp4[i] * r);
                    const float mult = sqrtf(fmaxf(1.0f - a * a, 0.f)); a4[i] = a; b4[i] = mult * ig * ucv[i]; }
                *(f32x4*)(A2 + fr * 68 + j0) = a4; *(f32x4*)(B2 + fr * 68 + j0) = b4; }
            wave_lds_sync();
#pragma unroll
            for (int i = 0; i < 16; ++i) { const int t = 16 * q4 + i; const int row = R0 + t;
                if (smp && (i & 7) == 0) h = p.state_lru[(size_t)(sbase + (t >> 3)) * 512 + ch];
                const float a = A2[i * 68 + lane], bb = B2[i * 68 + lane]; h = a * h + bb; Pc *= a;
                p.HSL[(size_t)row * 512 + ch] = f2bf(h); p.PP[(size_t)row * 512 + ch] = smp ? (bf16_t)0 : f2bf(Pc);
                if (smp && (i & 7) == 7) p.o_slru[(size_t)(sbase + (t >> 3)) * 512 + ch] = h; }
            wave_lds_sync();
        }
        if (!smp) { p.SUMH[(size_t)(b * 32 + c) * 512 + ch] = h; p.SUMP[(size_t)(b * 32 + c) * 512 + ch] = Pc; }
    }
}
__device__ __forceinline__ float gelu_tanh(float x) { const float z = 1.5957691216f * (x + 0.044715f * x * x * x); return x * fsigmoid(z); }
__device__ __forceinline__ void mixer2(const MixP& p, unsigned char* lds, int wid, int lane) {
    const int tid = wid * 64 + lane, fr = lane & 15, fq = lane >> 4;
    bf16_t* DL = (bf16_t*)lds;
    const int G_ = gridDim.x, cu_ = blockIdx.x; const bool remap = (G_ == 256);
    const int nmine = remap ? (((cu_ & 31) < 8) ? 2 : 1) : ((320 - cu_ + G_ - 1) / G_);
    for (int ui = 0; ui < nmine; ++ui) {
        const int unit = remap ? (ui == 0 ? cu_ : 256 + (cu_ >> 5) * 8 + (cu_ & 31)) : cu_ + ui * G_;
        const bool smp = unit >= 256; const int b = unit >> 5, c = unit & 31; const int sbase = (unit - 256) * 2;
        const int R0 = smp ? MP + (unit - 256) * 16 : b * 2048 + c * 64;
        { float carry[8];
#pragma unroll
          for (int k = 0; k < 8; ++k) carry[k] = 0.f;
          if (!smp) {
#pragma unroll 8
              for (int cc = 0; cc < c; ++cc) { const float* sh = p.SUMH + (size_t)(b * 32 + cc) * 512 + 8 * lane; const float* sp = p.SUMP + (size_t)(b * 32 + cc) * 512 + 8 * lane;
                  const f32x4 h0 = *(const f32x4*)sh, h1 = *(const f32x4*)(sh + 4), p0 = *(const f32x4*)sp, p1 = *(const f32x4*)(sp + 4);
#pragma unroll
                  for (int k = 0; k < 4; ++k) { carry[k] = h0[k] + p0[k] * carry[k]; carry[4 + k] = h1[k] + p1[k] * carry[4 + k]; } }
              if (c == 31 && wid == 0) { const float* sh = p.SUMH + (size_t)(b * 32 + 31) * 512 + 8 * lane; const float* sp = p.SUMP + (size_t)(b * 32 + 31) * 512 + 8 * lane;
                  const f32x4 h0 = *(const f32x4*)sh, h1 = *(const f32x4*)(sh + 4), p0 = *(const f32x4*)sp, p1 = *(const f32x4*)(sp + 4); f32x4 o0, o1;
#pragma unroll
                  for (int k = 0; k < 4; ++k) { o0[k] = h0[k] + p0[k] * carry[k]; o1[k] = h1[k] + p1[k] * carry[4 + k]; }
                  *(f32x4*)(p.o_plru + (size_t)b * 512 + 8 * lane) = o0; *(f32x4*)(p.o_plru + (size_t)b * 512 + 8 * lane + 4) = o1; } }
          const int nrr = smp ? 2 : 8;
#pragma unroll 2
          for (int rr = 0; rr < nrr; ++rr) { const int row = R0 + nrr * wid + rr;
              const u32x4 hw = *(const u32x4*)(p.HSL + (size_t)row * 512 + 8 * lane), pw = *(const u32x4*)(p.PP + (size_t)row * 512 + 8 * lane), gw = *(const u32x4*)(p.PROJ + (size_t)row * NIN + 512 + 8 * lane);
              unsigned ow[4];
#pragma unroll
              for (int k = 0; k < 4; ++k) { const unsigned hh = hw[k], pq = pw[k], gg = gw[k];
                  const float hs0 = __uint_as_float(hh << 16) + __uint_as_float(pq << 16) * carry[2 * k], hs1 = __uint_as_float(hh & 0xffff0000u) + __uint_as_float(pq & 0xffff0000u) * carry[2 * k + 1];
                  ow[k] = cvt_pk_bf16(gelu_tanh(__uint_as_float(gg << 16)) * hs0, gelu_tanh(__uint_as_float(gg & 0xffff0000u)) * hs1); }
              u32x4 o; o.x = ow[0]; o.y = ow[1]; o.z = ow[2]; o.w = ow[3];
              *(u32x4*)(p.Y + (size_t)row * 1024 + 8 * lane) = o; } }
        const int DLR0 = smp ? 0 : 15;
        if (smp) { const int ch = wid * 64 + lane, g = wid >> 1, win = 2 << g; const float rw = 1.0f / (float)win;
#pragma unroll 1
          for (int seg = 0; seg < 2; ++seg) { const int s = sbase + seg; float v[23];
#pragma unroll
              for (int e = 0; e < 15; ++e) v[e] = p.state_pool[((size_t)s * 15 + e) * 512 + ch];
#pragma unroll
              for (int e = 15; e < 23; ++e) v[e] = bf2f(p.PROJ[(size_t)(MP + s * 8 + e - 15) * NIN + 1024 + ch]);
#pragma unroll
              for (int t = 0; t < 8; ++t) { const float S2 = v[15 + t] + v[14 + t], S4 = S2 + (v[13 + t] + v[12 + t]), S8 = S4 + ((v[11 + t] + v[10 + t]) + (v[9 + t] + v[8 + t]));
                  const float S16 = S8 + (((v[7 + t] + v[6 + t]) + (v[5 + t] + v[4 + t])) + ((v[3 + t] + v[2 + t]) + (v[1 + t] + v[t])));
                  const float S = g == 0 ? S2 : (g == 1 ? S4 : (g == 2 ? S8 : S16));
                  DL[(seg * 8 + t) * 520 + ch] = f2bf(S * rw - v[15 + t]);
                  p.o_spool[((size_t)s * 15 + 7 + t) * 512 + ch] = v[15 + t]; }
#pragma unroll
              for (int k = 0; k < 7; ++k) p.o_spool[((size_t)s * 15 + k) * 512 + ch] = v[8 + k];
          } }
        else { const int ch = wid * 64 + lane, g = wid >> 1, win = 2 << g; const int t0 = c * 64;
          for (int i = tid; i < 79 * 64; i += NTHR) { const int e = i >> 6, cc = i & 63; const int tok = t0 + e - 15; u32x4 v = {0u, 0u, 0u, 0u};
              if (tok >= 0) v = *(const u32x4*)(p.PROJ + (size_t)(b * 2048 + tok) * NIN + 1024 + cc * 8);
              *(u32x4*)(DL + e * 520 + cc * 8) = v; }
          __syncthreads();
          float S = 0.f;
          for (int j = 0; j < win; ++j) S += bf2f(DL[(78 - j) * 520 + ch]);
#pragma unroll 8
          for (int t = 63; t >= 0; --t) { const int e = 15 + t; const float ut = bf2f(DL[e * 520 + ch]); const float cnt = (float)min(t0 + t + 1, win);
              DL[e * 520 + ch] = f2bf(S * __builtin_amdgcn_rcpf(cnt) - ut);
              if (t > 0) S = S - ut + bf2f(DL[(e - win) * 520 + ch]);
              if (c == 31 && t >= 49) p.o_ppool[((size_t)b * 15 + (t - 49)) * 512 + ch] = ut; }
        }
        __syncthreads();
        { const int g = wid >> 1, jh = wid & 1;
#pragma unroll 1
          for (int n = 0; n < 4; ++n) { bf16x8 X[4];
#pragma unroll
              for (int kk = 0; kk < 4; ++kk) X[kk] = *(const bf16x8*)(p.PwT + (size_t)g * 16384 + (64 * jh + 16 * n + fr) * 128 + 8 * fq + 32 * kk);
              const int j0 = g * 128 + 64 * jh + 16 * n + 4 * fq; const f32x4 sc4 = *(const f32x4*)(p.pool_scale + j0);
              const int nm = smp ? 1 : 4;
              for (int m = 0; m < nm; ++m) { f32x4 acc = {0.f, 0.f, 0.f, 0.f};
#pragma unroll
                  for (int kk = 0; kk < 4; ++kk) { const bf16x8 Yf = *(const bf16x8*)(DL + (DLR0 + 16 * m + fr) * 520 + g * 128 + 8 * fq + 32 * kk); acc = mfma16(X[kk], Yf, acc); }
                  u32x2 w; w.x = cvt_pk_bf16(acc[0] * sc4[0], acc[1] * sc4[1]); w.y = cvt_pk_bf16(acc[2] * sc4[2], acc[3] * sc4[3]);
                  *(u32x2*)(p.Y + (size_t)(R0 + 16 * m + fr) * 1024 + 512 + j0) = w; } } }
        __syncthreads();
    }
}
struct AttP { const bf16_t *Q, *KB, *VT; bf16_t* O; const float *cache_k, *cache_v; };
constexpr int ASTR = 528;
__device__ __forceinline__ void attn_prompt(const AttP& p, unsigned char* lds, int wid, int lane) {
    const int tid = wid * 64 + lane, fr = lane & 15, fq = lane >> 4;
    for (int unit = blockIdx.x; unit < 256; unit += gridDim.x) {
        const int b = unit >> 5, h = (unit >> 3) & 3, qb = unit & 7;
        const int rowbase = b * 2048 + qb * 256 + wid * 32;
        for (int i = tid; i < 256 * 32; i += NTHR) { const int r = i >> 5, cc = i & 31; *(u32x4*)(lds + r * ASTR + cc * 16) = *(const u32x4*)(p.KB + (size_t)(b * 256 + r) * 1024 + h * 256 + cc * 8); }
        const bf16_t* qp = p.Q + (size_t)(rowbase + fr) * 1024 + h * 256 + 8 * fq;
        __syncthreads();
        bf16x8 Pf[8][2]; float mxc[2][2], smc[2][2];
#pragma unroll
        for (int kh = 0; kh < 2; ++kh) {
            f32x4 S[8][2];
#pragma unroll
            for (int n = 0; n < 8; ++n) { S[n][0] = (f32x4){0.f, 0.f, 0.f, 0.f}; S[n][1] = (f32x4){0.f, 0.f, 0.f, 0.f}; }
#pragma unroll
            for (int kk = 0; kk < 8; ++kk) { const bf16x8 q0 = *(const bf16x8*)(qp + 32 * kk), q1 = *(const bf16x8*)(qp + 16 * 1024 + 32 * kk);
#pragma unroll
                for (int n = 0; n < 8; ++n) { const bf16x8 kf = *(const bf16x8*)(lds + (128 * kh + 16 * n + fr) * ASTR + (32 * kk + 8 * fq) * 2); S[n][0] = mfma16(kf, q0, S[n][0]); S[n][1] = mfma16(kf, q1, S[n][1]); }
                __builtin_amdgcn_sched_barrier(0); }
#pragma unroll
            for (int m = 0; m < 2; ++m) { float mx = -3.0e38f;
#pragma unroll
                for (int n = 0; n < 8; ++n) mx = fmaxf(mx, fmaxf(fmaxf(S[n][m][0], S[n][m][1]), fmaxf(S[n][m][2], S[n][m][3])));
                mx = fmaxf(mx, __shfl_xor(mx, 16)); mx = fmaxf(mx, __shfl_xor(mx, 32));
                float sum = 0.f;
#pragma unroll
                for (int n = 0; n < 8; ++n)
#pragma unroll
                    for (int i = 0; i < 4; ++i) { const float e = __builtin_amdgcn_exp2f(S[n][m][i] - mx); S[n][m][i] = e; sum += e; }
                sum += __shfl_xor(sum, 16); sum += __shfl_xor(sum, 32); mxc[kh][m] = mx; smc[kh][m] = sum; }
#pragma unroll
            for (int k2 = 0; k2 < 4; ++k2)
#pragma unroll
                for (int m = 0; m < 2; ++m) { u32x4 w; w.x = cvt_pk_bf16(S[2 * k2][m][0], S[2 * k2][m][1]); w.y = cvt_pk_bf16(S[2 * k2][m][2], S[2 * k2][m][3]);
                    w.z = cvt_pk_bf16(S[2 * k2 + 1][m][0], S[2 * k2 + 1][m][1]); w.w = cvt_pk_bf16(S[2 * k2 + 1][m][2], S[2 * k2 + 1][m][3]); Pf[4 * kh + k2][m] = __builtin_bit_cast(bf16x8, w); }
            __builtin_amdgcn_sched_barrier(0);
        }
        float rr[2], fin[2];
#pragma unroll
        for (int m = 0; m < 2; ++m) { const float mm = fmaxf(mxc[0][m], mxc[1][m]); const float c0 = __builtin_amdgcn_exp2f(mxc[0][m] - mm), c1 = __builtin_amdgcn_exp2f(mxc[1][m] - mm);
            rr[m] = __builtin_amdgcn_exp2f(fminf(fmaxf(mxc[0][m] - mxc[1][m], -80.f), 80.f)); fin[m] = c1 / (smc[0][m] * c0 + smc[1][m] * c1); }
        __syncthreads();
        for (int i = tid; i < 256 * 32; i += NTHR) { const int r = i >> 5, cc = i & 31; *(u32x4*)(lds + r * ASTR + cc * 16) = *(const u32x4*)(p.VT + (size_t)(h * 256 + r) * 2048 + b * 256 + cc * 8); }
        __syncthreads();
#pragma unroll 1
        for (int dh = 0; dh < 2; ++dh) { f32x4 O[8][2];
#pragma unroll
            for (int dn = 0; dn < 8; ++dn) { O[dn][0] = (f32x4){0.f, 0.f, 0.f, 0.f}; O[dn][1] = (f32x4){0.f, 0.f, 0.f, 0.f};
                const unsigned char* vrow = lds + (dh * 128 + dn * 16 + fr) * ASTR;
#pragma unroll
                for (int k2 = 0; k2 < 8; ++k2) { const u32x2 lo = *(const u32x2*)(vrow + (32 * k2 + 4 * fq) * 2), hi = *(const u32x2*)(vrow + (32 * k2 + 16 + 4 * fq) * 2);
                    u32x4 w; w.x = lo.x; w.y = lo.y; w.z = hi.x; w.w = hi.y; const bf16x8 vf = __builtin_bit_cast(bf16x8, w);
                    if (k2 == 4) { O[dn][0] = O[dn][0] * rr[0]; O[dn][1] = O[dn][1] * rr[1]; }
                    O[dn][0] = mfma16(vf, Pf[k2][0], O[dn][0]); O[dn][1] = mfma16(vf, Pf[k2][1], O[dn][1]); }
                __builtin_amdgcn_sched_barrier(0); }
#pragma unroll
            for (int dn = 0; dn < 8; ++dn)
#pragma unroll
                for (int m = 0; m < 2; ++m) { const f32x4 o = O[dn][m] * fin[m]; u32x2 w; w.x = cvt_pk_bf16(o[0], o[1]); w.y = cvt_pk_bf16(o[2], o[3]);
                    *(u32x2*)(p.O + (size_t)(rowbase + 16 * m + fr) * 1024 + h * 256 + dh * 128 + dn * 16 + 4 * fq) = w; } }
        __syncthreads();
    }
}
__device__ __forceinline__ void attn_sample(const AttP& p, unsigned char* lds, int wid, int lane) {
    const int tid = wid * 64 + lane, fr = lane & 15, fq = lane >> 4;
    float* SS = (float*)lds;
    float* PT = (float*)(lds + 8320);
    float* OP = (float*)(lds + 16640);
    for (int unit = blockIdx.x; unit < 512; unit += gridDim.x) {
        const int s = unit >> 2, h = unit & 3;
        bf16x8 Qf[8];
#pragma unroll
        for (int kk = 0; kk < 8; ++kk) { u32x4 w = {0u, 0u, 0u, 0u}; if (fr < 8) w = *(const u32x4*)(p.Q + (size_t)(MP + 8 * s + fr) * 1024 + h * 256 + 32 * kk + 8 * fq); Qf[kk] = __builtin_bit_cast(bf16x8, w); }
#pragma unroll
        for (int n = 0; n < 2; ++n) { const int key = 32 * wid + 16 * n + fr; const float* kp = p.cache_k + (((size_t)(s * 256 + key)) * 4 + h) * 256 + 8 * fq;
            f32x4 acc = {0.f, 0.f, 0.f, 0.f};
#pragma unroll
            for (int kk = 0; kk < 8; ++kk) { const f32x4 a0 = *(const f32x4*)(kp + 32 * kk), a1 = *(const f32x4*)(kp + 32 * kk + 4);
                u32x4 w; w.x = cvt_pk_bf16(a0[0], a0[1]); w.y = cvt_pk_bf16(a0[2], a0[3]); w.z = cvt_pk_bf16(a1[0], a1[1]); w.w = cvt_pk_bf16(a1[2], a1[3]);
                acc = mfma16(__builtin_bit_cast(bf16x8, w), Qf[kk], acc); }
            if (fr < 8) *(f32x4*)(SS + fr * 260 + 32 * wid + 16 * n + 4 * fq) = acc; }
        __syncthreads();
        { const f32x4 v = *(const f32x4*)(SS + wid * 260 + 4 * lane);
          const float mx = wave_max(fmaxf(fmaxf(v[0], v[1]), fmaxf(v[2], v[3])));
          f32x4 e; float sum = 0.f;
#pragma unroll
          for (int i = 0; i < 4; ++i) { e[i] = __builtin_amdgcn_exp2f(v[i] - mx); sum += e[i]; }
          sum = wave_sum(sum); const float is = 1.0f / sum;
#pragma unroll
          for (int i = 0; i < 4; ++i) PT[(4 * lane + i) * 8 + wid] = e[i] * is; }
        __syncthreads();
        { float o[8][4];
#pragma unroll
          for (int q = 0; q < 8; ++q)
#pragma unroll
              for (int i = 0; i < 4; ++i) o[q][i] = 0.f;
          const float* vp = p.cache_v + (((size_t)(s * 256 + 32 * wid)) * 4 + h) * 256 + 4 * lane;
#pragma unroll 8
          for (int kq = 0; kq < 32; ++kq) { const f32x4 v = *(const f32x4*)(vp + (size_t)kq * 1024); const f32x4 pa = *(const f32x4*)(PT + (32 * wid + kq) * 8), pb = *(const f32x4*)(PT + (32 * wid + kq) * 8 + 4);
#pragma unroll
              for (int q = 0; q < 4; ++q)
#pragma unroll
                  for (int i = 0; i < 4; ++i) { o[q][i] += pa[q] * v[i]; o[4 + q][i] += pb[q] * v[i]; } }
#pragma unroll
          for (int q = 0; q < 8; ++q) *(f32x4*)(OP + (size_t)(wid * 8 + q) * 256 + 4 * lane) = (f32x4){o[q][0], o[q][1], o[q][2], o[q][3]}; }
        __syncthreads();
        { const int q = tid >> 6, d4 = (tid & 63) * 4; f32x4 a = {0.f, 0.f, 0.f, 0.f};
#pragma unroll
          for (int w = 0; w < 8; ++w) a += *(const f32x4*)(OP + (size_t)(w * 8 + q) * 256 + d4);
          u32x2 ww; ww.x = cvt_pk_bf16(a[0], a[1]); ww.y = cvt_pk_bf16(a[2], a[3]);
          *(u32x2*)(p.O + (size_t)(MP + 8 * s + q) * 1024 + h * 256 + d4) = ww; }
        __syncthreads();
    }
}
struct SmallEpi { int mode; const bf16_t* xin; float* xout; bf16_t* xb; float* ss; float alpha; bf16_t* O; const float* ssin; float mul; };
__device__ __forceinline__ void small_gemm(unsigned char* lds, const bf16_t* A, const bf16_t* Bt, int K, const SmallEpi& E, int wid, int lane) {
    const int tid = wid * 64 + lane, fr = lane & 15, fq = lane >> 4;
    float* RED = (float*)lds;
    for (int t = blockIdx.x; t < 256; t += gridDim.x) {
        const int r0 = (t >> 4) * 64, c0 = (t & 15) * 64; const int np = K >> 6, base = np >> 3, rem = np & 7; const int cnt = base + (wid < rem ? 1 : 0), start = wid * base + (wid < rem ? wid : rem);
        const bf16_t* ap = A + (size_t)(r0 + fr) * K + start * 64 + 8 * fq; const bf16_t* bp = Bt + (size_t)(c0 + fr) * K + start * 64 + 8 * fq;
        f32x4 acc[4][4];
#pragma unroll
        for (int m = 0; m < 4; ++m)
#pragma unroll
            for (int n = 0; n < 4; ++n) acc[m][n] = (f32x4){0.f, 0.f, 0.f, 0.f};
        bf16x8 a[2][4], b[2][4];
#pragma unroll
        for (int hh = 0; hh < 2; ++hh)
#pragma unroll
            for (int m = 0; m < 4; ++m) { a[hh][m] = *(const bf16x8*)(ap + (size_t)16 * m * K + 32 * hh); b[hh][m] = *(const bf16x8*)(bp + (size_t)16 * m * K + 32 * hh); }
        for (int st = 0; st < cnt; ++st) { bf16x8 an[2][4], bn[2][4];
            const int nx = (st + 1 < cnt) ? st + 1 : st;
#pragma unroll
            for (int hh = 0; hh < 2; ++hh)
#pragma unroll
                for (int m = 0; m < 4; ++m) { an[hh][m] = *(const bf16x8*)(ap + (size_t)16 * m * K + 64 * nx + 32 * hh); bn[hh][m] = *(const bf16x8*)(bp + (size_t)16 * m * K + 64 * nx + 32 * hh); }
#pragma unroll
            for (int hh = 0; hh < 2; ++hh)
#pragma unroll
                for (int m = 0; m < 4; ++m)
#pragma unroll
                    for (int n = 0; n < 4; ++n) acc[m][n] = mfma16(b[hh][n], a[hh][m], acc[m][n]);
#pragma unroll
            for (int hh = 0; hh < 2; ++hh)
#pragma unroll
                for (int m = 0; m < 4; ++m) { a[hh][m] = an[hh][m]; b[hh][m] = bn[hh][m]; } }
#pragma unroll
        for (int m = 0; m < 4; ++m)
#pragma unroll
            for (int n = 0; n < 4; ++n) { const int row = 16 * m + fr; *(f32x4*)(RED + (size_t)(wid * 64 + row) * 64 + ((16 * n + 4 * fq + 4 * row) & 63)) = acc[m][n]; }
        __syncthreads();
        { const int rr = tid >> 3, cc = (tid & 7) * 8; f32x4 v0 = {0.f, 0.f, 0.f, 0.f}, v1 = {0.f, 0.f, 0.f, 0.f};
#pragma unroll
          for (int w = 0; w < 8; ++w) { v0 += *(const f32x4*)(RED + (size_t)(w * 64 + rr) * 64 + ((cc + 4 * rr) & 63)); v1 += *(const f32x4*)(RED + (size_t)(w * 64 + rr) * 64 + ((cc + 4 + 4 * rr) & 63)); }
          const int row = r0 + rr, col = c0 + cc;
          if (E.mode == 0) { const u32x4 xw = *(const u32x4*)(E.xin + (size_t)row * 1024 + col);
              const f32x4 a0 = {__uint_as_float(xw.x << 16), __uint_as_float(xw.x & 0xffff0000u), __uint_as_float(xw.y << 16), __uint_as_float(xw.y & 0xffff0000u)};
              const f32x4 a1 = {__uint_as_float(xw.z << 16), __uint_as_float(xw.z & 0xffff0000u), __uint_as_float(xw.w << 16), __uint_as_float(xw.w & 0xffff0000u)};
              v0 = a0 + v0 * E.alpha; v1 = a1 + v1 * E.alpha;
              if (E.xout) { *(f32x4*)(E.xout + (size_t)row * 1024 + col) = v0; *(f32x4*)(E.xout + (size_t)row * 1024 + col + 4) = v1; }
              if (E.xb) { u32x4 w; w.x = cvt_pk_bf16(v0[0], v0[1]); w.y = cvt_pk_bf16(v0[2], v0[3]); w.z = cvt_pk_bf16(v1[0], v1[1]); w.w = cvt_pk_bf16(v1[2], v1[3]); *(u32x4*)(E.xb + (size_t)row * 1024 + col) = w; }
              float sq = (v0[0] * v0[0] + v0[1] * v0[1]) + (v0[2] * v0[2] + v0[3] * v0[3]) + (v1[0] * v1[0] + v1[1] * v1[1]) + (v1[2] * v1[2] + v1[3] * v1[3]);
              sq += __shfl_xor(sq, 1); sq += __shfl_xor(sq, 2); sq += __shfl_xor(sq, 4);
              if ((tid & 7) == 0) unsafeAtomicAdd(E.ss + row, sq); }
          else { const float rs = pg8::rstd_of(E.ssin[row]) * E.mul; v0 = v0 * rs; v1 = v1 * rs;
              u32x4 w; w.x = cvt_pk_bf16(v0[0], v0[1]); w.y = cvt_pk_bf16(v0[2], v0[3]); w.z = cvt_pk_bf16(v1[0], v1[1]); w.w = cvt_pk_bf16(v1[2], v1[3]); *(u32x4*)(E.O + (size_t)row * 1024 + col) = w; } }
        __syncthreads();
    }
}
#ifndef PHMASK
#define PHMASK 0xffff
#endif
#define SS1 ((float*)(ws + WS_SS))
#define SS2 (SS1 + MT)
#define SS3 (SS1 + 2 * MT)
#define SS4 (SS1 + 3 * MT)
#define SS0 ((float*)(ws + WS_SS0))
#define SSM ((float*)(ws + WS_SSM))
#define W1GU ((bf16_t*)(ws + WS_W1GU))
#define W1D ((bf16_t*)(ws + WS_W1D))
#define W2GU ((bf16_t*)(ws + WS_W2GU))
#define W2D ((bf16_t*)(ws + WS_W2D))
#define WIN ((bf16_t*)(ws + WS_WIN))
#define WOUT ((bf16_t*)(ws + WS_WOUT))
#define WQ ((bf16_t*)(ws + WS_WQ))
#define WKV ((bf16_t*)(ws + WS_WKV))
#define WO ((bf16_t*)(ws + WS_WO))
#define WAT ((bf16_t*)(ws + WS_WAT))
#define WXT ((bf16_t*)(ws + WS_WXT))
#define PWT ((bf16_t*)(ws + WS_PWT))
#define XB ((bf16_t*)(ws + WS_XB))
#define X ((float*)(ws + WS_X))
#define H ((bf16_t*)(ws + WS_H))
#define PROJ ((bf16_t*)(ws + WS_PROJ))
#define MEMB ((bf16_t*)(ws + WS_MEMB))
#define KB ((bf16_t*)(ws + WS_KB))
#define VT ((bf16_t*)(ws + WS_VT))
#define Yb ((bf16_t*)(ws + WS_Y))
#define Qb ((bf16_t*)(ws + WS_Q))
#define Ob ((bf16_t*)(ws + WS_O))
#define HSL ((bf16_t*)(ws + WS_HSL))
#define PPb ((bf16_t*)(ws + WS_PP))
#define SUMH ((float*)(ws + WS_SUMH))
#define SUMP ((float*)(ws + WS_SUMP))

typedef const __attribute__((address_space(4))) Args CArgs0;
__global__ void __launch_bounds__(NTHR, 2) fwd_megakernel(Args args) {
    __shared__ __attribute__((aligned(16))) unsigned char lds_raw[136 * 1024];
    cg::grid_group grid = cg::this_grid();
    { volatile LAS unsigned* st0 = (volatile LAS unsigned*)((LAS unsigned char*)lds_raw + 139248); if (threadIdx.x < 4) st0[threadIdx.x] = 0u; }
    __syncthreads();
    unsigned char* A0_ws = ((CArgs0*)__builtin_amdgcn_kernarg_segment_ptr())->ws;
    XcdBarrier xbar = xcd_barrier_post((unsigned*)(A0_ws + WS_BAR), (volatile LAS unsigned*)((LAS unsigned char*)lds_raw + 139248));
    PG8_LAS unsigned char* ldsL = (PG8_LAS unsigned char*)lds_raw;
    unsigned char* lds = lds_raw;
    const int G = gridDim.x, cu = blockIdx.x; (void)args;
    typedef const __attribute__((address_space(4))) Args CArgs;
    CArgs* ap0 = (CArgs*)__builtin_amdgcn_kernarg_segment_ptr();
#define PHASE_ARGS CArgs* A_ = ap0; asm volatile("" : "+s"(A_)); const float* const __attribute__((address_space(4)))* in = A_->in; unsigned char* ws = A_->ws; float* out = A_->out; (void)in; (void)ws; (void)out; int tid_ = threadIdx.x; asm volatile("" : "+v"(tid_)); const int tid = tid_, lane = tid_ & 63, wid = __builtin_amdgcn_readfirstlane(tid_ >> 6); (void)tid; (void)lane; (void)wid;

#if (PHMASK >> 0) & 1
    { PHASE_ARGS
    {
        float* scr = (float*)(lds + wid * 16640);
        const int gw = cu * NWAVES + wid, NGW = G * NWAVES;
        constexpr int I_GU = 16 * 44, I_D = 44 * 16, I_IN = 16 * 24, I_SQ = 16 * 16, I_HD = 1, I_PG = 4;
        constexpr int NITEMS = 2 * (2 * I_GU + I_D) + I_IN + 5 * I_SQ + 2 * 8 * I_HD + 4 * I_PG;
        for (int it = gw; it < NITEMS; it += NGW) {
            int r = it;
            if (r < I_GU) { tr_item(in[9], DM, FF, in[8], W1GU, 128, 256, 0, scr, r, lane); continue; } r -= I_GU;
            if (r < I_GU) { tr_item(in[10], DM, FF, in[8], W1GU, 128, 256, 128, scr, r, lane); continue; } r -= I_GU;
            if (r < I_D) { tr_item(in[11], FF, DM, nullptr, W1D, DM, 0, 0, scr, r, lane); continue; } r -= I_D;
            if (r < I_GU) { tr_item(in[31], DM, FF, in[30], W2GU, 128, 256, 0, scr, r, lane); continue; } r -= I_GU;
            if (r < I_GU) { tr_item(in[32], DM, FF, in[30], W2GU, 128, 256, 128, scr, r, lane); continue; } r -= I_GU;
            if (r < I_D) { tr_item(in[33], FF, DM, nullptr, W2D, DM, 0, 0, scr, r, lane); continue; } r -= I_D;
            if (r < I_IN) { tr_item(in[13], DM, NIN, in[12], WIN, NIN, 0, 0, scr, r, lane); continue; } r -= I_IN;
            if (r < I_SQ) { tr_item(in[23], DM, DM, nullptr, WOUT, DM, 0, 0, scr, r, lane); continue; } r -= I_SQ;
            if (r < I_SQ) { tr_item(in[26], DM, DM, in[24], WQ, DM, 0, 0, scr, r, lane); continue; } r -= I_SQ;
            if (r < I_SQ) { tr_item(in[27], DM, DM, in[25], WKV, DM, 0, 0, scr, r, lane); continue; } r -= I_SQ;
            if (r < I_SQ) { tr_item(in[28], DM, DM, in[25], WKV, DM, 0, 1024, scr, r, lane); continue; } r -= I_SQ;
            if (r < I_SQ) { tr_item(in[29], DM, DM, nullptr, WO, DM, 0, 0, scr, r, lane); continue; } r -= I_SQ;
            if (r < 8 * I_HD) { const int g = r / I_HD; tr_item(in[16] + g * 4096, 64, 64, nullptr, WAT + g * 4096, 64, 0, 0, scr, r % I_HD, lane); continue; } r -= 8 * I_HD;
            if (r < 8 * I_HD) { const int g = r / I_HD; tr_item(in[18] + g * 4096, 64, 64, nullptr, WXT + g * 4096, 64, 0, 0, scr, r % I_HD, lane); continue; } r -= 8 * I_HD;
            { const int g = r / I_PG; tr_item(in[21] + g * 16384, 128, 128, nullptr, PWT + g * 16384, 128, 0, 0, scr, r % I_PG, lane); }
        }
        for (int m2 = gw; m2 < (MT + 2048) / 2; m2 += NGW) {
            const int m = 2 * m2; const float* src; bf16_t* dst; float* sso;
            if (m < MP) { src = in[0] + (size_t)m * DM; dst = XB + (size_t)m * DM; sso = SS0 + m; }
            else if (m < MT) { src = in[1] + (size_t)(m - MP) * DM; dst = XB + (size_t)m * DM; sso = SS0 + m; }
            else { src = in[2] + (size_t)(m - MT) * DM; dst = MEMB + (size_t)(m - MT) * DM; sso = SSM + (m - MT); }
            const f32x4* xr = (const f32x4*)src + lane; f32x4 v[8]; float s0 = 0.f, s1 = 0.f;
#pragma unroll
            for (int j = 0; j < 8; ++j) v[j] = xr[64 * j];
#pragma unroll
            for (int j = 0; j < 4; ++j) { s0 += (v[j][0] * v[j][0] + v[j][1] * v[j][1]) + (v[j][2] * v[j][2] + v[j][3] * v[j][3]); s1 += (v[4 + j][0] * v[4 + j][0] + v[4 + j][1] * v[4 + j][1]) + (v[4 + j][2] * v[4 + j][2] + v[4 + j][3] * v[4 + j][3]); }
            s0 = wave_sum(s0); s1 = wave_sum(s1);
            u32x2* o8 = (u32x2*)dst + lane;
#pragma unroll
            for (int j = 0; j < 8; ++j) { u32x2 w; w.x = cvt_pk_bf16(v[j][0], v[j][1]); w.y = cvt_pk_bf16(v[j][2], v[j][3]); o8[64 * j] = w; }
            if (lane == 0) { sso[0] = s0; sso[1] = s1; }
        }
    }
    }
#endif
    if (__builtin_expect(A0_ws == nullptr, 0)) grid.sync();
    xcd_barrier(xbar);
#if (PHMASK >> 1) & 1
    { PHASE_ARGS
    { pg8::Gemm g{XB, W1GU, MT, NGU, DM}; pg8::StaticOrder S; S.init(MT, NGU, G, cu); pg8::EpiSwiGLU E{H, SS0, FF};
      pg8::gemm_phase<pg8::EpiSwiGLU, pg8::StaticOrder, true, true>(ldsL, g, S, E); }
    }
#endif
    xcd_barrier(xbar);
#if (PHMASK >> 2) & 1
    { PHASE_ARGS
    { pg8::Gemm g{H, W1D, MP, DM, FF}; pg8::StaticOrder S; S.init(MP, DM, G, cu); pg8::EpiResid E{XB, nullptr, XB, SS1, 0.5f};
      pg8::gemm_phase<pg8::EpiResid, pg8::StaticOrder, true, true>(ldsL, g, S, E);
      SmallEpi se{0, XB + (size_t)MP * DM, nullptr, XB + (size_t)MP * DM, SS1 + MP, 0.5f, nullptr, nullptr, 0.f};
      small_gemm(lds, H + (size_t)MP * FF, W1D, FF, se, wid, lane); }
    }
#endif
    xcd_barrier(xbar);
#if (PHMASK >> 3) & 1
    { PHASE_ARGS
    { pg8::Gemm g{XB, WIN, MT, NIN, DM}; pg8::StaticOrder S; S.init(MT, NIN, G, cu); pg8::EpiScaleBf16 E{PROJ, NIN, SS1, 1.0f};
      pg8::gemm_phase<pg8::EpiScaleBf16, pg8::StaticOrder, true, true>(ldsL, g, S, E); }
    { pg8::Gemm g{MEMB, WKV, 2048, 2048, DM}; pg8::StaticOrder S; S.init(2048, 2048, G, (cu + G - 152) % G); pg8::EpiKV E{out + OUT_PMK, out + OUT_PMV, KB, SSM};
      pg8::gemm_phase<pg8::EpiKV, pg8::StaticOrder, true, true>(ldsL, g, S, E); }
    { pg8::Gemm g{WKV + (size_t)1024 * DM, MEMB, 1024, 2048, DM}; pg8::StaticOrder S; S.init(1024, 2048, G, (cu + G - 216) % G); pg8::EpiVT E{VT, SSM};
      pg8::gemm_phase<pg8::EpiVT, pg8::StaticOrder, true, true>(ldsL, g, S, E); }
    }
#endif
    xcd_barrier(xbar);
#define MIXP_INIT {PROJ, in[14], in[15], in[17], in[19], in[20], in[3], in[4], in[5], in[22], WAT, WXT, PWT, HSL, PPb, Yb, SUMH, SUMP, \
            out + OUT_PCONV, out + OUT_PLRU, out + OUT_PPOOL, out + OUT_SCONV, out + OUT_SLRU, out + OUT_SPOOL}
#if (PHMASK >> 4) & 1
    { PHASE_ARGS
    { MixP mp MIXP_INIT; mixer1(mp, lds, wid, lane); }
    }
#endif
    xcd_barrier(xbar);
#if (PHMASK >> 5) & 1
    { PHASE_ARGS
    { MixP mp MIXP_INIT; mixer2(mp, lds, wid, lane); }
    }
#endif
    xcd_barrier(xbar);
#if (PHMASK >> 6) & 1
    { PHASE_ARGS
    { pg8::Gemm g{Yb, WOUT, MP, DM, DM}; pg8::StaticOrder S; S.init(MP, DM, G, cu); pg8::EpiResid E{XB, nullptr, XB, SS2, 1.0f};
      pg8::gemm_phase<pg8::EpiResid, pg8::StaticOrder, true, true>(ldsL, g, S, E);
      SmallEpi se{0, XB + (size_t)MP * DM, nullptr, XB + (size_t)MP * DM, SS2 + MP, 1.0f, nullptr, nullptr, 0.f};
      small_gemm(lds, Yb + (size_t)MP * DM, WOUT, DM, se, wid, lane); }
    }
#endif
    xcd_barrier(xbar);
#if (PHMASK >> 7) & 1
    { PHASE_ARGS
    { pg8::Gemm g{XB, WQ, MP, DM, DM}; pg8::StaticOrder S; S.init(MP, DM, G, cu); pg8::EpiScaleBf16 E{Qb, DM, SS2, 0.0625f * 1.4426950408889634f};
      pg8::gemm_phase<pg8::EpiScaleBf16, pg8::StaticOrder, true, true>(ldsL, g, S, E);
      SmallEpi se{1, nullptr, nullptr, nullptr, nullptr, 0.f, Qb + (size_t)MP * DM, SS2 + MP, 0.0625f * 1.4426950408889634f};
      small_gemm(lds, XB + (size_t)MP * DM, WQ, DM, se, wid, lane); }
    }
#endif
    xcd_barrier(xbar);
#if (PHMASK >> 8) & 1
    { PHASE_ARGS
    { AttP ap{Qb, KB, VT, Ob, in[6], in[7]};
#pragma unroll 1
      for (int st = 0; st < 2; ++st) {
#ifndef NO_ATT_P
        if ((st ^ (cu & 1)) == 0) attn_prompt(ap, lds, wid, lane);
#endif
#ifndef NO_ATT_S
        if ((st ^ (cu & 1)) != 0) attn_sample(ap, lds, wid, lane);
#endif
      } }
    }
#endif
    xcd_barrier(xbar);
#if (PHMASK >> 9) & 1
    { PHASE_ARGS
    { pg8::Gemm g{Ob, WO, MP, DM, DM}; pg8::StaticOrder S; S.init(MP, DM, G, cu); pg8::EpiResid E{XB, nullptr, XB, SS3, 1.0f};
      pg8::gemm_phase<pg8::EpiResid, pg8::StaticOrder, true, true>(ldsL, g, S, E);
      SmallEpi se{0, XB + (size_t)MP * DM, nullptr, XB + (size_t)MP * DM, SS3 + MP, 1.0f, nullptr, nullptr, 0.f};
      small_gemm(lds, Ob + (size_t)MP * DM, WO, DM, se, wid, lane); }
    }
#endif
    xcd_barrier(xbar);
#if (PHMASK >> 10) & 1
    { PHASE_ARGS
    { pg8::Gemm g{XB, W2GU, MT, NGU, DM}; pg8::StaticOrder S; S.init(MT, NGU, G, cu); pg8::EpiSwiGLU E{H, SS3, FF};
      pg8::gemm_phase<pg8::EpiSwiGLU, pg8::StaticOrder, true, true>(ldsL, g, S, E); }
    }
#endif
    xcd_barrier(xbar);
#if (PHMASK >> 11) & 1
    { PHASE_ARGS
    { pg8::Gemm g{H, W2D, MP, DM, FF}; pg8::StaticOrder S; S.init(MP, DM, G, cu); pg8::EpiResid E{XB, nullptr, XB, SS4, 0.5f};
      pg8::gemm_phase<pg8::EpiResid, pg8::StaticOrder, true, true>(ldsL, g, S, E);
      SmallEpi se{0, XB + (size_t)MP * DM, nullptr, XB + (size_t)MP * DM, SS4 + MP, 0.5f, nullptr, nullptr, 0.f};
      small_gemm(lds, H + (size_t)MP * FF, W2D, FF, se, wid, lane); }
    }
#endif
    xcd_barrier(xbar);
#if (PHMASK >> 12) & 1
    { PHASE_ARGS
    { const int gw = cu * NWAVES + wid, NGW = G * NWAVES; const f32x4* gn = (const f32x4*)in[34];
      f32x4 g0[2], g1[2];
#pragma unroll
      for (int j = 0; j < 2; ++j) { g0[j] = gn[2 * lane + 128 * j]; g1[j] = gn[2 * lane + 128 * j + 1]; }
      for (int m = gw; m < MT; m += NGW) { const float rs = pg8::rstd_of(SS4[m]); const u32x4* xr = (const u32x4*)(XB + (size_t)m * DM) + lane; f32x4* orow = (f32x4*)(out + OUT_Y + (size_t)m * DM);
#pragma unroll
          for (int j = 0; j < 2; ++j) { const u32x4 xw = xr[64 * j];
              const f32x4 a0 = {__uint_as_float(xw.x << 16), __uint_as_float(xw.x & 0xffff0000u), __uint_as_float(xw.y << 16), __uint_as_float(xw.y & 0xffff0000u)};
              const f32x4 a1 = {__uint_as_float(xw.z << 16), __uint_as_float(xw.z & 0xffff0000u), __uint_as_float(xw.w << 16), __uint_as_float(xw.w & 0xffff0000u)};
              orow[2 * lane + 128 * j] = a0 * rs * g0[j]; orow[2 * lane + 128 * j + 1] = a1 * rs * g1[j]; } } }
    }
#endif
}

extern "C" void kernel_launch(void* const* d_in, const int* in_sizes, int n_in, void* d_out, int out_size, void* d_ws, size_t ws_size, hipStream_t stream) {
    static int grid = 0;
    if (grid == 0) {
        if (n_in != 35 || (size_t)out_size != OUT_TOTAL || ws_size < WS_END) { fprintf(stderr, "kernel_launch: unexpected shapes: n_in %d out %d ws %zu (need %zu)\n", n_in, out_size, ws_size, (size_t)WS_END); grid = -1; return; }
        int dev = 0, cus = 0, per = 0;
        hipGetDevice(&dev); hipDeviceGetAttribute(&cus, hipDeviceAttributeMultiprocessorCount, dev);
        hipOccupancyMaxActiveBlocksPerMultiprocessor(&per, fwd_megakernel, NTHR, 0);
        if (per < 1) { fprintf(stderr, "kernel_launch: occupancy query says %d blocks/CU\n", per); grid = -1; return; }
        grid = cus;
    }
    if (grid < 0) return;
    hipMemsetAsync((char*)d_ws + WS_BAR, 0, WS_SS + WS_SS_BYTES, stream);
    Args a{};
    for (int i = 0; i < 35; ++i) a.in[i] = (const float*)d_in[i];
    a.out = (float*)d_out; a.ws = (unsigned char*)d_ws;
    void* kargs[] = {&a};
    hipError_t e = hipLaunchCooperativeKernel((void*)fwd_megakernel, dim3(grid), dim3(NTHR), kargs, 0, stream);
    if (e != hipSuccess) fprintf(stderr, "kernel_launch: cooperative launch failed: %s (grid %d)\n", hipGetErrorString(e), grid);
}
```

```cpp
#include <hip/hip_runtime.h>
#include <hip/hip_cooperative_groups.h>
#include <cstdio>
#include <cstdint>
namespace cg = cooperative_groups;
namespace pg8 {
#define PG8_LAS __attribute__((address_space(3)))
typedef unsigned short bf16_t;
typedef short bf16x8 __attribute__((ext_vector_type(8)));
typedef float f32x4 __attribute__((ext_vector_type(4)));
typedef unsigned u32x4 __attribute__((ext_vector_type(4)));
constexpr int BM = 256, BK = 64, HALF = 128, HTB = HALF * BK * 2  , STAGE_BYTES = 8 * HTB, NXCD = 8, WGM = 8;

__host__ __device__ __forceinline__ int lds_byte(int r, int c) { const int st = (r >> 4) * 2 + (c >> 5), rr = r & 15, cc = c & 31, ob = rr * 64 + cc * 2; return st * 1024 + (ob ^ (((ob >> 9) & 1) << 5)); }
__host__ __device__ __forceinline__ void stage_rc(int b, int& R, int& C) { const int st = b / 1024, sb = b % 1024, swz = sb ^ (((sb >> 9) & 1) << 5); R = (st >> 1) * 16 + swz / 64; C = (st & 1) * 32 + (swz % 64) / 2; }
__host__ __device__ __forceinline__ int perm32(int rho) { const int n = rho >> 4, i = rho & 15; return 8 * (i >> 2) + 4 * n + (i & 3); }

struct Unit { int pm, pn; };
struct Gemm { const bf16_t* A; const bf16_t* Bt; int M, N, K; };

struct StaticOrder {
    int nM, nN, nwg, G, c;
    __host__ __device__ void init(int M, int N, int G_, int c_) { nM = M / BM; nN = N / BM; nwg = nM * nN; G = G_; c = c_; }
    __host__ __device__ bool next(int i, Unit& u) const {
        const long L = (long)i * G + c; if (L >= nwg) return false;
        int wgid = (int)L; { const int q = nwg / NXCD, r = nwg % NXCD, xcd = wgid % NXCD, off = wgid / NXCD; wgid = (xcd < r ? xcd * (q + 1) : r * (q + 1) + (xcd - r) * q) + off; }
        const int nig = WGM * nN, gid = wgid / nig, fm = gid * WGM, gsz = (nM - fm) < WGM ? (nM - fm) : WGM;
        u.pm = fm + ((wgid % nig) % gsz); u.pn = (wgid % nig) / gsz; return true;
    }
    __device__ __forceinline__ void a_ready(const Unit&) const {}
    __device__ __forceinline__ void done(const Unit&) const {}
};

__device__ __forceinline__ unsigned cvt_pk_bf16(float lo, float hi) { unsigned r; asm volatile("v_cvt_pk_bf16_f32 %0, %1, %2" : "=v"(r) : "v"(lo), "v"(hi)); return r; }
typedef float f32x2 __attribute__((ext_vector_type(2)));
__device__ __forceinline__ f32x2 gelu_pk(f32x2 v) {
    const f32x2 av = __builtin_elementwise_abs(v), d = av * 0.2316418882f + 1.0f;
    f32x2 t; t.x = __builtin_amdgcn_rcpf(d.x); t.y = __builtin_amdgcn_rcpf(d.y);
    f32x2 q = t * 0.5307027145f + (-0.7265760135f); q = q * t + 0.7107068705f; q = q * t + (-0.142248368f); q = q * t + 0.127414796f; q = q * t;
    const f32x2 s = (v * v) * (-0.72134752044f);
    f32x2 e; e.x = __builtin_amdgcn_exp2f(s.x); e.y = __builtin_amdgcn_exp2f(s.y);
    const f32x2 m = v * (q * e), r = v - m;
    f32x2 o; o.x = v.x < 0.f ? m.x : r.x; o.y = v.y < 0.f ? m.y : r.y; return o;
}

constexpr int MP_ROWS = 16384;
__device__ __forceinline__ float rstd_of(float ss) { return rsqrtf(ss * (1.0f / 1024.0f) + 1e-6f); }
__device__ __forceinline__ float fsigmoid(float x) { return __builtin_amdgcn_rcpf(1.0f + __expf(-x)); }
struct EpiSwiGLU {
    static constexpr bool PERM = true, AFTER_DRAIN = false;
    bf16_t* H; const float* ss; int ldh;
    __device__ __forceinline__ void operator()(const f32x4 (&acc)[2][2][4][2], const Unit& u, int wr, int wc, int fr, int fq) const {
#pragma unroll
        for (int ai = 0; ai < 2; ++ai)
#pragma unroll
            for (int m = 0; m < 4; ++m) { const int row = u.pm * BM + ai * HALF + wr * 64 + m * 16 + fr; const float rs = rstd_of(ss[row]);
                float hv[8];
#pragma unroll
                for (int n = 0; n < 2; ++n)
#pragma unroll
                    for (int i = 0; i < 4; ++i) { const float g = acc[ai][0][m][n][i] * rs, uu = acc[ai][1][m][n][i] * rs; hv[n * 4 + i] = g * uu * fsigmoid(g); }
                u32x4 w; w.x = cvt_pk_bf16(hv[0], hv[1]); w.y = cvt_pk_bf16(hv[2], hv[3]); w.z = cvt_pk_bf16(hv[4], hv[5]); w.w = cvt_pk_bf16(hv[6], hv[7]);
                *(u32x4*)(H + (size_t)row * ldh + u.pn * HALF + wc * 32 + 8 * fq) = w; }
    }
};
struct EpiResid {
    static constexpr bool PERM = true, AFTER_DRAIN = false;
    const bf16_t* xin; float* xout; bf16_t* xb; float* ss; float alpha;
    __device__ __forceinline__ void operator()(const f32x4 (&acc)[2][2][4][2], const Unit& u, int wr, int wc, int fr, int fq) const {
        const int rowb = u.pm * BM + wr * 64 + fr, colb = u.pn * BM + wc * 32 + 8 * fq;
#pragma unroll
        for (int am = 0; am < 4; ++am) { const int ai = am >> 1, m0 = (am & 1) * 2; u32x4 xw[2][2];
#pragma unroll
            for (int mm = 0; mm < 2; ++mm)
#pragma unroll
                for (int bj = 0; bj < 2; ++bj) xw[mm][bj] = *(const u32x4*)(xin + (size_t)(rowb + ai * HALF + (m0 + mm) * 16) * 1024 + colb + bj * HALF);
#pragma unroll
            for (int mm = 0; mm < 2; ++mm) { const int m = m0 + mm; const int row = rowb + ai * HALF + m * 16; float sq = 0.f;
#pragma unroll
                for (int bj = 0; bj < 2; ++bj) { const int col = colb + bj * HALF; const u32x4 w4 = xw[mm][bj];
                    const f32x4 a0 = {__uint_as_float(w4.x << 16), __uint_as_float(w4.x & 0xffff0000u), __uint_as_float(w4.y << 16), __uint_as_float(w4.y & 0xffff0000u)};
                    const f32x4 a1 = {__uint_as_float(w4.z << 16), __uint_as_float(w4.z & 0xffff0000u), __uint_as_float(w4.w << 16), __uint_as_float(w4.w & 0xffff0000u)};
                    const f32x4 v0 = a0 + acc[ai][bj][m][0] * alpha, v1 = a1 + acc[ai][bj][m][1] * alpha;
                    if (xout) { *(f32x4*)(xout + (size_t)row * 1024 + col) = v0; *(f32x4*)(xout + (size_t)row * 1024 + col + 4) = v1; }
                    if (xb) { u32x4 w; w.x = cvt_pk_bf16(v0[0], v0[1]); w.y = cvt_pk_bf16(v0[2], v0[3]); w.z = cvt_pk_bf16(v1[0], v1[1]); w.w = cvt_pk_bf16(v1[2], v1[3]);
                        *(u32x4*)(xb + (size_t)row * 1024 + col) = w; }
                    sq += (v0[0] * v0[0] + v0[1] * v0[1]) + (v0[2] * v0[2] + v0[3] * v0[3]) + (v1[0] * v1[0] + v1[1] * v1[1]) + (v1[2] * v1[2] + v1[3] * v1[3]); }
                sq += __shfl_xor(sq, 16); sq += __shfl_xor(sq, 32);
                if (fq == 0) unsafeAtomicAdd(ss + row, sq); } }
    }
};
struct EpiScaleBf16 {
    static constexpr bool PERM = true, AFTER_DRAIN = false;
    bf16_t* O; int ldc; const float* ss; float mul;
    __device__ __forceinline__ void operator()(const f32x4 (&acc)[2][2][4][2], const Unit& u, int wr, int wc, int fr, int fq) const {
#pragma unroll
        for (int ai = 0; ai < 2; ++ai)
#pragma unroll
            for (int m = 0; m < 4; ++m) { const int row = u.pm * BM + ai * HALF + wr * 64 + m * 16 + fr; const float rs = rstd_of(ss[row]) * mul;
#pragma unroll
                for (int bj = 0; bj < 2; ++bj) { const int col = u.pn * BM + bj * HALF + wc * 32 + 8 * fq;
                    const f32x4 v0 = acc[ai][bj][m][0] * rs, v1 = acc[ai][bj][m][1] * rs;
                    u32x4 w; w.x = cvt_pk_bf16(v0[0], v0[1]); w.y = cvt_pk_bf16(v0[2], v0[3]); w.z = cvt_pk_bf16(v1[0], v1[1]); w.w = cvt_pk_bf16(v1[2], v1[3]);
                    *(u32x4*)(O + (size_t)row * ldc + col) = w; } }
    }
};
struct EpiKV {
    static constexpr bool PERM = true, AFTER_DRAIN = false;
    float* outK; float* outV; bf16_t* KB; const float* ss;
    __device__ __forceinline__ void operator()(const f32x4 (&acc)[2][2][4][2], const Unit& u, int wr, int wc, int fr, int fq) const {
#pragma unroll
        for (int ai = 0; ai < 2; ++ai)
#pragma unroll
            for (int m = 0; m < 4; ++m) { const int row = u.pm * BM + ai * HALF + wr * 64 + m * 16 + fr; const float rs = rstd_of(ss[row]);
#pragma unroll
                for (int bj = 0; bj < 2; ++bj) { const int col = u.pn * BM + bj * HALF + wc * 32 + 8 * fq;
                    const f32x4 v0 = acc[ai][bj][m][0] * rs, v1 = acc[ai][bj][m][1] * rs;
                    if (col < 1024) { *(f32x4*)(outK + (size_t)row * 1024 + col) = v0; *(f32x4*)(outK + (size_t)row * 1024 + col + 4) = v1;
                        u32x4 w; w.x = cvt_pk_bf16(v0[0], v0[1]); w.y = cvt_pk_bf16(v0[2], v0[3]); w.z = cvt_pk_bf16(v1[0], v1[1]); w.w = cvt_pk_bf16(v1[2], v1[3]);
                        *(u32x4*)(KB + (size_t)row * 1024 + col) = w; }
                    else { *(f32x4*)(outV + (size_t)row * 1024 + col - 1024) = v0; *(f32x4*)(outV + (size_t)row * 1024 + col - 1024 + 4) = v1; } } }
    }
};
struct EpiVT {
    static constexpr bool PERM = true, AFTER_DRAIN = false;
    bf16_t* VT; const float* ss;
    __device__ __forceinline__ void operator()(const f32x4 (&acc)[2][2][4][2], const Unit& u, int wr, int wc, int fr, int fq) const {
#pragma unroll
        for (int bj = 0; bj < 2; ++bj) { const int col = u.pn * BM + bj * HALF + wc * 32 + 8 * fq;
            const f32x4 s0 = *(const f32x4*)(ss + col), s1 = *(const f32x4*)(ss + col + 4);
            f32x4 r0, r1;
#pragma unroll
            for (int i = 0; i < 4; ++i) { r0[i] = rstd_of(s0[i]); r1[i] = rstd_of(s1[i]); }
#pragma unroll
            for (int ai = 0; ai < 2; ++ai)
#pragma unroll
                for (int m = 0; m < 4; ++m) { const int row = u.pm * BM + ai * HALF + wr * 64 + m * 16 + fr;
                    const f32x4 v0 = acc[ai][bj][m][0] * r0, v1 = acc[ai][bj][m][1] * r1;
                    u32x4 w; w.x = cvt_pk_bf16(v0[0], v0[1]); w.y = cvt_pk_bf16(v0[2], v0[3]); w.z = cvt_pk_bf16(v1[0], v1[1]); w.w = cvt_pk_bf16(v1[2], v1[3]);
                    *(u32x4*)(VT + (size_t)row * 2048 + col) = w; } }
    }
};
template <class Epi, class Sched, bool ALIGN_EPI = false, bool SP2 = false>
__device__ __forceinline__ void gemm_phase(PG8_LAS unsigned char* lds, const Gemm g, const Sched& S, const Epi& E) {
    const int tid = threadIdx.x, wid = __builtin_amdgcn_readfirstlane(tid >> 6), lane = tid & 63, wr = wid >> 2, wc = wid & 3, fr = lane & 15, fq = lane >> 4;
    const int K = g.K, nt = K / BK;
    unsigned voffA[2], voffB[2];
#pragma unroll
    for (int i = 0; i < 2; ++i) { int R, C; stage_rc(tid * 16 + i * 8192, R, C); const int Rb = Epi::PERM ? ((R & ~31) + perm32(R & 31)) : R;
        voffA[i] = (unsigned)(R * K + C) * 2u; voffB[i] = (unsigned)(Rb * K + C) * 2u; }
    const size_t kstep = (size_t)(BK * 2);
    const size_t hstep = (size_t)HALF * K * 2;
    const size_t tstep = 2 * hstep;
    const unsigned ldsw = (unsigned)wid * 1024u;
    const int aoff = lds_byte(wr * 64 + fr, fq * 8), boff = lds_byte(wc * 32 + fr, fq * 8);
#define PG8_SA(b, h) (((b) * 2 + (h)) * HTB)
#define PG8_SB(b, h) ((4 + (b) * 2 + (h)) * HTB)
#define PG8_STAGE(bufoff, gbase, voff) do { _Pragma("unroll") for (int _i = 0; _i < 2; ++_i) \
        __builtin_amdgcn_global_load_lds((const unsigned*)((const char*)(gbase) + (voff)[_i]), (PG8_LAS unsigned*)(lds + (bufoff) + ldsw + _i * 8192), 16, 0, 0); } while (0)
#define PG8_LDA(dst, b, h) do { _Pragma("unroll") for (int m = 0; m < 4; ++m) _Pragma("unroll") for (int k = 0; k < 2; ++k) dst[m][k] = *(const PG8_LAS bf16x8*)(lds + PG8_SA(b, h) + aoff + m * 2048 + k * 1024); } while (0)
#define PG8_LDB(dst, b, h) do { _Pragma("unroll") for (int n = 0; n < 2; ++n) _Pragma("unroll") for (int k = 0; k < 2; ++k) dst[n][k] = *(const PG8_LAS bf16x8*)(lds + PG8_SB(b, h) + boff + n * 2048 + k * 1024); } while (0)
#define PG8_MMA(ai, bj, At, Bt) do { __builtin_amdgcn_s_setprio(1); _Pragma("unroll") for (int m = 0; m < 4; ++m) _Pragma("unroll") for (int n = 0; n < 2; ++n) _Pragma("unroll") for (int k = 0; k < 2; ++k) \
        acc[ai][bj][m][n] = __builtin_amdgcn_mfma_f32_16x16x32_bf16(Bt[n][k], At[m][k], acc[ai][bj][m][n], 0, 0, 0); __builtin_amdgcn_s_setprio(0); } while (0)
#define PG8_WAIT_V(n) asm volatile("s_waitcnt vmcnt(" #n ")" ::: "memory")
#define PG8_WAIT_L(n) asm volatile("s_waitcnt lgkmcnt(" #n ")" ::: "memory")
#define PG8_BAR __builtin_amdgcn_s_barrier()
#define PG8_SCHED __builtin_amdgcn_sched_barrier(0)
    Unit cur, nxt; int ui = 0;
    if (!S.next(0, cur)) return;
    f32x4 acc[2][2][4][2];
#pragma unroll
    for (int a = 0; a < 2; ++a)
#pragma unroll
        for (int b = 0; b < 2; ++b)
#pragma unroll
            for (int m = 0; m < 4; ++m)
#pragma unroll
                for (int n = 0; n < 2; ++n) acc[a][b][m][n] = (f32x4){0.f, 0.f, 0.f, 0.f};
    bf16x8 At[4][2], B0[2][2], B1[2][2];
    const char* cA = (const char*)g.A + (size_t)cur.pm * tstep; const char* cB = (const char*)g.Bt + (size_t)cur.pn * tstep;
    S.a_ready(cur);
    if constexpr (SP2) {
        PG8_STAGE(PG8_SB(0, 0), cB, voffB); PG8_STAGE(PG8_SB(0, 1), cB + hstep, voffB); PG8_STAGE(PG8_SA(0, 0), cA, voffA); PG8_STAGE(PG8_SA(0, 1), cA + hstep, voffA);
        if (wr == 1) PG8_BAR;
        PG8_WAIT_V(2); PG8_BAR;
        PG8_STAGE(PG8_SB(1, 0), cB + kstep, voffB); PG8_STAGE(PG8_SA(1, 0), cA + kstep, voffA); PG8_STAGE(PG8_SB(1, 1), cB + hstep + kstep, voffB);
        PG8_WAIT_V(6); PG8_BAR;
    } else {
        PG8_STAGE(PG8_SB(0, 0), cB, voffB); PG8_STAGE(PG8_SA(0, 0), cA, voffA); PG8_STAGE(PG8_SB(0, 1), cB + hstep, voffB); PG8_STAGE(PG8_SA(0, 1), cA + hstep, voffA);
        if (wr == 1) PG8_BAR;
        PG8_WAIT_V(4); PG8_BAR;
        PG8_STAGE(PG8_SB(1, 0), cB + kstep, voffB); PG8_STAGE(PG8_SA(1, 0), cA + kstep, voffA); PG8_STAGE(PG8_SB(1, 1), cB + hstep + kstep, voffB);
        PG8_WAIT_V(6); PG8_BAR;
    }
    for (;;) {
        const bool has_next = S.next(ui + 1, nxt);
        const char* nA = has_next ? (const char*)g.A + (size_t)nxt.pm * tstep : cA; const char* nB = has_next ? (const char*)g.Bt + (size_t)nxt.pn * tstep : cB;
        for (int t = 0; t < nt; t += 2) {
            const bool last = (t == nt - 2);
            const char* a1 = cA + (size_t)(t + 1) * kstep;
            const char* a2 = last ? nA : cA + (size_t)(t + 2) * kstep; const char* b2 = last ? nB : cB + (size_t)(t + 2) * kstep;
            const char* a3 = a2 + kstep; const char* b3 = b2 + kstep;
            if (last && has_next) S.a_ready(nxt);
            if constexpr (SP2) {
            PG8_LDB(B0, 0, 0); PG8_LDB(B1, 0, 1); PG8_SCHED; PG8_LDA(At, 0, 0); PG8_STAGE(PG8_SA(1, 1), a1 + hstep, voffA);
            PG8_WAIT_V(8); PG8_WAIT_L(0); PG8_BAR; PG8_MMA(0, 0, At, B0); PG8_MMA(0, 1, At, B1); PG8_BAR; PG8_SCHED;
            PG8_LDA(At, 0, 1); PG8_STAGE(PG8_SB(0, 0), b2, voffB); PG8_STAGE(PG8_SB(0, 1), b2 + hstep, voffB); PG8_STAGE(PG8_SA(0, 0), a2, voffA);
            PG8_WAIT_V(8); PG8_WAIT_L(0); PG8_BAR; PG8_MMA(1, 0, At, B0); PG8_MMA(1, 1, At, B1); PG8_BAR; PG8_SCHED;
            PG8_LDB(B0, 1, 0); PG8_LDB(B1, 1, 1); PG8_SCHED; PG8_LDA(At, 1, 0); PG8_STAGE(PG8_SA(0, 1), a2 + hstep, voffA);
            PG8_WAIT_V(8); PG8_WAIT_L(0); PG8_BAR; PG8_MMA(0, 0, At, B0); PG8_MMA(0, 1, At, B1); PG8_BAR; PG8_SCHED;
            PG8_LDA(At, 1, 1); PG8_STAGE(PG8_SB(1, 0), b3, voffB); PG8_STAGE(PG8_SB(1, 1), b3 + hstep, voffB); PG8_STAGE(PG8_SA(1, 0), a3, voffA);
            PG8_WAIT_V(8); PG8_WAIT_L(0); PG8_BAR; PG8_MMA(1, 0, At, B0); PG8_MMA(1, 1, At, B1); PG8_BAR; PG8_SCHED;
            } else {
            PG8_LDB(B0, 0, 0); PG8_SCHED; PG8_LDA(At, 0, 0); PG8_STAGE(PG8_SA(1, 1), a1 + hstep, voffA);
            PG8_WAIT_L(8); PG8_BAR; PG8_WAIT_L(0); PG8_MMA(0, 0, At, B0); PG8_BAR; PG8_SCHED;
            PG8_LDB(B1, 0, 1); PG8_STAGE(PG8_SB(0, 0), b2, voffB);
            PG8_BAR; PG8_WAIT_L(0); PG8_MMA(0, 1, At, B1); PG8_BAR;
            PG8_LDA(At, 0, 1); PG8_STAGE(PG8_SA(0, 0), a2, voffA);
            PG8_BAR; PG8_WAIT_L(0); PG8_MMA(1, 0, At, B0); PG8_BAR; PG8_SCHED;
            PG8_STAGE(PG8_SB(0, 1), b2 + hstep, voffB);
            PG8_WAIT_V(6); PG8_BAR; PG8_MMA(1, 1, At, B1); PG8_BAR;
            PG8_LDB(B0, 1, 0); PG8_SCHED; PG8_LDA(At, 1, 0); PG8_STAGE(PG8_SA(0, 1), a2 + hstep, voffA);
            PG8_WAIT_L(8); PG8_BAR; PG8_WAIT_L(0); PG8_MMA(0, 0, At, B0); PG8_BAR; PG8_SCHED;
            PG8_LDB(B1, 1, 1); PG8_STAGE(PG8_SB(1, 0), b3, voffB);
            PG8_BAR; PG8_WAIT_L(0); PG8_MMA(0, 1, At, B1); PG8_BAR;
            PG8_LDA(At, 1, 1); PG8_STAGE(PG8_SA(1, 0), a3, voffA);
            PG8_BAR; PG8_WAIT_L(0); PG8_MMA(1, 0, At, B0); PG8_BAR; PG8_SCHED;
            PG8_STAGE(PG8_SB(1, 1), b3 + hstep, voffB);
            PG8_WAIT_V(6); PG8_BAR; PG8_MMA(1, 1, At, B1); PG8_BAR;
            }
        }
        if constexpr (ALIGN_EPI) { if (wr == 0) PG8_BAR; }
        if constexpr (!Epi::AFTER_DRAIN) { E(acc, cur, wr, wc, fr, fq); S.done(cur); }
        if (!has_next) break;
#pragma unroll
        for (int a = 0; a < 2; ++a)
#pragma unroll
            for (int b = 0; b < 2; ++b)
#pragma unroll
                for (int m = 0; m < 4; ++m)
#pragma unroll
                    for (int n = 0; n < 2; ++n) acc[a][b][m][n] = (f32x4){0.f, 0.f, 0.f, 0.f};
        cur = nxt; cA = nA; cB = nB; ++ui;
        if constexpr (ALIGN_EPI) { if (wr == 1) PG8_BAR; }
    }
    PG8_WAIT_V(0);
    if constexpr (!ALIGN_EPI) { if (wr == 0) PG8_BAR; }
    PG8_BAR;
    if constexpr (Epi::AFTER_DRAIN) { E.fused(acc, cur, wr, wc, fr, fq, lds, wid, lane); S.done(cur); }
#undef PG8_SA
#undef PG8_SB
#undef PG8_STAGE
#undef PG8_LDA
#undef PG8_LDB
#undef PG8_MMA
#undef PG8_WAIT_V
#undef PG8_WAIT_L
#undef PG8_BAR
#undef PG8_SCHED
}
}
using pg8::fsigmoid; using pg8::bf16_t; using pg8::bf16x8; using pg8::f32x4; using pg8::u32x4; using pg8::cvt_pk_bf16;
typedef unsigned u32x2 __attribute__((ext_vector_type(2)));
constexpr int MP = 16384, MS = 1024, MT = 17408, DM = 1024, FF = 2816, NGU = 5632, NIN = 1536;
constexpr int NTHR = 512, NWAVES = 8;
constexpr size_t OUT_Y = 0, OUT_PCONV = 17825792, OUT_PLRU = 17838080, OUT_PPOOL = 17842176, OUT_PMK = 17903616, OUT_PMV = 20000768,
                 OUT_SCONV = 22097920, OUT_SLRU = 22294528, OUT_SPOOL = 22360064, OUT_TOTAL = 23343104;
constexpr size_t al256(size_t x) { return (x + 255) & ~(size_t)255; }
constexpr size_t WS_BAR = 0;
constexpr size_t WS_SS = 16384;
constexpr size_t WS_SS_BYTES = 4 * (size_t)MT * 4;
constexpr size_t WS_SS0 = al256(WS_SS + WS_SS_BYTES);
constexpr size_t WS_SSM = al256(WS_SS0 + (size_t)MT * 4);
constexpr size_t WS_W1GU = al256(WS_SSM + 2048 * 4);
constexpr size_t WS_W1D = WS_W1GU + (size_t)NGU * DM * 2;
constexpr size_t WS_W2GU = WS_W1D + (size_t)DM * FF * 2;
constexpr size_t WS_W2D = WS_W2GU + (size_t)NGU * DM * 2;
constexpr size_t WS_WIN = WS_W2D + (size_t)DM * FF * 2;
constexpr size_t WS_WOUT = WS_WIN + (size_t)NIN * DM * 2;
constexpr size_t WS_WQ = WS_WOUT + (size_t)DM * DM * 2;
constexpr size_t WS_WKV = WS_WQ + (size_t)DM * DM * 2;
constexpr size_t WS_WO = WS_WKV + (size_t)2 * DM * DM * 2;
constexpr size_t WS_WAT = WS_WO + (size_t)DM * DM * 2;
constexpr size_t WS_WXT = WS_WAT + 8 * 64 * 64 * 2;
constexpr size_t WS_PWT = WS_WXT + 8 * 64 * 64 * 2;
constexpr size_t WS_XB = al256(WS_PWT + 4 * 128 * 128 * 2);
constexpr size_t WS_X = WS_XB + (size_t)MT * DM * 2;
constexpr size_t WS_H = WS_X + (size_t)MT * DM * 4;
constexpr size_t WS_PROJ = WS_H + (size_t)MT * FF * 2;
constexpr size_t WS_MEMB = WS_PROJ + (size_t)MT * NIN * 2;
constexpr size_t WS_KB = WS_MEMB + (size_t)2048 * DM * 2;
constexpr size_t WS_VT = WS_KB + (size_t)2048 * DM * 2;
constexpr size_t WS_Y = WS_VT + (size_t)2048 * DM * 2;
constexpr size_t WS_Q = WS_Y + (size_t)MT * DM * 2;
constexpr size_t WS_O = WS_Q + (size_t)MT * DM * 2;
constexpr size_t WS_HSL = WS_O + (size_t)MT * DM * 2;
constexpr size_t WS_PP = WS_HSL + (size_t)MT * 512 * 2;
constexpr size_t WS_SUMH = WS_PP + (size_t)MT * 512 * 2;
constexpr size_t WS_SUMP = WS_SUMH + (size_t)8 * 32 * 512 * 4;
constexpr size_t WS_END = WS_SUMP + (size_t)8 * 32 * 512 * 4;

#define LAS __attribute__((address_space(3)))
struct Args { const float* in[35]; float* out; unsigned char* ws; };

__device__ __forceinline__ float bf2f(bf16_t v) { return __uint_as_float((unsigned)v << 16); }
__device__ __forceinline__ bf16_t f2bf(float f) { unsigned u = __float_as_uint(f); u += 0x7fffu + ((u >> 16) & 1u); return (bf16_t)(u >> 16); }
__device__ __forceinline__ void wave_lds_sync() { asm volatile("s_waitcnt lgkmcnt(0)" ::: "memory"); }
__device__ __forceinline__ float wave_sum(float v) {
#pragma unroll
    for (int o = 1; o < 64; o <<= 1) v += __shfl_xor(v, o);
    return v;
}
__device__ __forceinline__ float wave_max(float v) {
#pragma unroll
    for (int o = 1; o < 64; o <<= 1) v = fmaxf(v, __shfl_xor(v, o));
    return v;
}
__device__ __forceinline__ f32x4 mfma16(bf16x8 a, bf16x8 b, f32x4 c) { return __builtin_amdgcn_mfma_f32_16x16x32_bf16(a, b, c, 0, 0, 0); }

__device__ __forceinline__ void tr_item(const float* W, int K, int N, const float* g, bf16_t* WT, int grp, int gmul, int goff, float* scr, int item, int lane) {
    const int nblk = N / 64, kb = item / nblk, nb = item % nblk, k0 = 64 * kb, n0 = 64 * nb; const int lr = lane >> 4, lc = (lane & 15) * 4;
    f32x4 v[16];
#pragma unroll
    for (int i = 0; i < 16; ++i) v[i] = *(const f32x4*)(W + (size_t)(k0 + 4 * i + lr) * N + n0 + lc);
#pragma unroll
    for (int i = 0; i < 16; ++i) { const int k = 4 * i + lr; const float gg = g ? g[k0 + k] : 1.0f; float* d = scr + k * 65 + lc; d[0] = v[i][0] * gg; d[1] = v[i][1] * gg; d[2] = v[i][2] * gg; d[3] = v[i][3] * gg; }
    wave_lds_sync();
    const int c = lane & 7;
#pragma unroll
    for (int j = 0; j < 8; ++j) { const int n = (lane >> 3) + 8 * j; const float* s = scr + (8 * c) * 65 + n; const int nn = n0 + n; const int dr = (nn / grp) * gmul + goff + nn % grp;
        u32x4 o; o.x = cvt_pk_bf16(s[0 * 65], s[1 * 65]); o.y = cvt_pk_bf16(s[2 * 65], s[3 * 65]); o.z = cvt_pk_bf16(s[4 * 65], s[5 * 65]); o.w = cvt_pk_bf16(s[6 * 65], s[7 * 65]);
        *(u32x4*)(WT + (size_t)dr * K + k0 + 8 * c) = o; }
    wave_lds_sync();
}
__device__ __forceinline__ void row_to_bf16(const float* xrow, bf16_t* orow, float* ssout, int lane) {
    const f32x4* xr = (const f32x4*)xrow + lane; f32x4 v[4]; float s = 0.f;
#pragma unroll
    for (int j = 0; j < 4; ++j) { v[j] = xr[64 * j]; s += (v[j][0] * v[j][0] + v[j][1] * v[j][1]) + (v[j][2] * v[j][2] + v[j][3] * v[j][3]); }
    s = wave_sum(s);
    u32x2* o8 = (u32x2*)orow + lane;
#pragma unroll
    for (int j = 0; j < 4; ++j) { u32x2 w; w.x = cvt_pk_bf16(v[j][0], v[j][1]); w.y = cvt_pk_bf16(v[j][2], v[j][3]); o8[64 * j] = w; }
    if (lane == 0) *ssout = s;
}
#define XB_TMO      128
#define XB_XCNT(j)  (256  + 64 * (j))
#define XB_XSUB(j)  (1280 + 64 * (j))
#define XB_XGEN(j)  (2304 + 64 * (j))
#define XB_TOP      3328
#define XB_TOPGEN   3392
#define XCD_BAR_WORDS 3456
#define XB_SPIN_CAP (1u << 18)

__device__ __forceinline__ unsigned xb_ld(unsigned* p)              { return __hip_atomic_load(p, __ATOMIC_RELAXED, __HIP_MEMORY_SCOPE_AGENT); }
__device__ __forceinline__ unsigned xb_add(unsigned* p, unsigned v) { return __hip_atomic_fetch_add(p, v, __ATOMIC_RELAXED, __HIP_MEMORY_SCOPE_AGENT); }
__device__ __forceinline__ unsigned xb_xcc_id() { return (unsigned)__builtin_amdgcn_s_getreg((3 << 11) | 20) & 0xFu; }
#define XB_SPIN(cond, bar) do { unsigned _sp = 0; while (cond) { __builtin_amdgcn_s_sleep(1); \
    if ((++_sp & 255u) == 0u) { if (xb_ld(&(bar)[XB_TMO])) break; if (_sp > XB_SPIN_CAP) { atomicAdd(&(bar)[XB_TMO], 1u); break; } } } } while (0)

struct XcdBarrier {
    unsigned* bar; unsigned x;
    volatile LAS unsigned* st;
};

__device__ __forceinline__ XcdBarrier xcd_barrier_post(unsigned* bar, volatile LAS unsigned* st) {
    XcdBarrier b; b.bar = bar; b.x = xb_xcc_id(); b.st = st;
    if (threadIdx.x == 0) (void)xb_add(&bar[XB_XCNT(b.x)], 1u);
    return b;
}
__device__ __forceinline__ void xcd_barrier_complete(unsigned* bar, unsigned x, unsigned& nloc, unsigned& nx) {
    const unsigned G = gridDim.x * gridDim.y * gridDim.z;
    unsigned sum, cnt, mine, sp = 0u;
    for (;;) {
        sum = 0u; cnt = 0u; mine = 0u;
#pragma unroll
        for (unsigned j = 0; j < 16; ++j) { const unsigned c = xb_ld(&bar[XB_XCNT(j)]); sum += c; cnt += (c > 0u) ? 1u : 0u; mine = (j == x) ? c : mine; }
        if (sum == G) break;
        __builtin_amdgcn_s_sleep(1);
        if ((++sp & 255u) == 0u) { if (xb_ld(&bar[XB_TMO])) break; if (sp > XB_SPIN_CAP) { atomicAdd(&bar[XB_TMO], 1u); break; } }
    }
    nloc = mine > 0u ? mine : 1u; nx = cnt > 0u ? cnt : 1u;
}

__device__ __forceinline__ void xcd_barrier(const XcdBarrier& b) {
    asm volatile("s_waitcnt vmcnt(0)" ::: "memory");
    __syncthreads();
    if (threadIdx.x == 0) {
        unsigned* bar = b.bar;
        __builtin_amdgcn_s_waitcnt(0);
        unsigned nloc = b.st[0], nx = b.st[1];
        if (nloc == 0u) { xcd_barrier_complete(bar, b.x, nloc, nx); b.st[0] = nloc; b.st[1] = nx; }
        const unsigned old = xb_add(&bar[XB_XSUB(b.x)], 1u);
        const unsigned gen = old / nloc;
        if (old + 1u == (gen + 1u) * nloc) {
            __builtin_amdgcn_fence(__ATOMIC_RELEASE, "agent");
            asm volatile("s_waitcnt vmcnt(0)" ::: "memory");
            const unsigned og = xb_add(&bar[XB_TOP], 1u);
            const unsigned tg = og / nx;
            if (og + 1u == (tg + 1u) * nx) xb_add(&bar[XB_TOPGEN], 1u);
            else XB_SPIN(xb_ld(&bar[XB_TOPGEN]) == tg, bar);
            __builtin_amdgcn_fence(__ATOMIC_ACQUIRE, "agent");
            xb_add(&bar[XB_XGEN(b.x)], 1u);
            asm volatile("s_waitcnt vmcnt(0)" ::: "memory");
        } else {
            XB_SPIN(xb_ld(&bar[XB_XGEN(b.x)]) == gen, bar);
            __builtin_amdgcn_fence(__ATOMIC_ACQUIRE, "agent");
            asm volatile("s_waitcnt vmcnt(0)" ::: "memory");
        }
    }
    __syncthreads();
}
struct MixP {
    const bf16_t* PROJ; const float *conv_w, *conv_b, *lru_ba, *lru_bx, *lru_lambda, *state_conv, *state_lru, *state_pool, *pool_scale;
    const bf16_t *WaT, *WxT, *PwT; bf16_t *HSL, *PP, *Y; float *SUMH, *SUMP; float *o_pconv, *o_plru, *o_ppool, *o_sconv, *o_slru, *o_spool;
};
__device__ __forceinline__ void mixer1(const MixP& p, unsigned char* lds, int wid, int lane) {
    unsigned char* wl = lds + wid * 12288;
    bf16_t* UC = (bf16_t*)wl; float* A2 = (float*)(wl + 2304); float* B2 = (float*)(wl + 2304 + 4352); float* TAB = (float*)(wl + 2304 + 8704);
    const int ch = wid * 64 + lane, fr = lane & 15, fq = lane >> 4;
    TAB[lane] = p.lru_ba[ch]; TAB[64 + lane] = p.lru_bx[ch]; TAB[128 + lane] = -8.0f * log1pf(expf(-p.lru_lambda[ch]));
    const float cw0 = p.conv_w[ch], cw1 = p.conv_w[512 + ch], cw2 = p.conv_w[1024 + ch], cw3 = p.conv_w[1536 + ch], cb = p.conv_b[ch];
    bf16x8 XA[4][2], XI[4][2];
#pragma unroll
    for (int n = 0; n < 4; ++n)
#pragma unroll
        for (int kk = 0; kk < 2; ++kk) { XA[n][kk] = *(const bf16x8*)(p.WaT + wid * 4096 + (16 * n + fr) * 64 + 8 * fq + 32 * kk); XI[n][kk] = *(const bf16x8*)(p.WxT + wid * 4096 + (16 * n + fr) * 64 + 8 * fq + 32 * kk); }
    wave_lds_sync();
    for (int unit = blockIdx.x; unit < 320; unit += gridDim.x) {
        const bool smp = unit >= 256; const int b = unit >> 5, c = unit & 31; const int sbase = (unit - 256) * 2;
        const int R0 = smp ? MP + (unit - 256) * 16 : b * 2048 + c * 64; const int nq = smp ? 1 : 4;
        float u1 = 0.f, u2 = 0.f, u3 = 0.f, h = 0.f, Pc = 1.0f;
        if (!smp && c > 0) { u1 = bf2f(p.PROJ[(size_t)(R0 - 1) * NIN + ch]); u2 = bf2f(p.PROJ[(size_t)(R0 - 2) * NIN + ch]); u3 = bf2f(p.PROJ[(size_t)(R0 - 3) * NIN + ch]); }
        for (int q4 = 0; q4 < nq; ++q4) {
#pragma unroll
            for (int i = 0; i < 16; ++i) { const int t = 16 * q4 + i; const int row = R0 + t;
                if (smp && (i & 7) == 0) { const float* sc = p.state_conv + (size_t)(sbase + (t >> 3)) * 1536 + ch; u3 = sc[0]; u2 = sc[512]; u1 = sc[1024]; }
                const float u = bf2f(p.PROJ[(size_t)row * NIN + ch]);
                const float uc = cb + cw3 * u + cw2 * u1 + cw1 * u2 + cw0 * u3; u3 = u2; u2 = u1; u1 = u;
                UC[i * 72 + lane] = f2bf(uc);
                if (smp) { if ((i & 7) >= 5) p.o_sconv[((size_t)(sbase + (t >> 3)) * 3 + ((i & 7) - 5)) * 512 + ch] = u; }
                else if (c == 31 && t >= 61) p.o_pconv[((size_t)b * 3 + (t - 61)) * 512 + ch] = u;
            }
            wave_lds_sync();
            const bf16x8 Y0 = *(const bf16x8*)(UC + fr * 72 + 8 * fq), Y1 = *(const bf16x8*)(UC + fr * 72 + 8 * fq + 32);
#pragma unroll
            for (int n = 0; n < 4; ++n) { f32x4 aR = {0.f, 0.f, 0.f, 0.f}, aI = {0.f, 0.f, 0.f, 0.f};
                aR = mfma16(XA[n][0], Y0, aR); aR = mfma16(XA[n][1], Y1, aR); aI = mfma16(XI[n][0], Y0, aI); aI = mfma16(XI[n][1], Y1, aI);
                const int j0 = 16 * n + 4 * fq; const f32x4 ba4 = *(const f32x4*)(TAB + j0), bx4 = *(const f32x4*)(TAB + 64 + j0), sp4 = *(const f32x4*)(TAB + 128 + j0);
                const u32x2 ucw = *(const u32x2*)(UC + fr * 72 + j0);
                const float ucv[4] = {__uint_as_float(ucw.x << 16), __uint_as_float(ucw.x & 0xffff0000u), __uint_as_float(ucw.y << 16), __uint_as_float(ucw.y & 0xffff0000u)};
                f32x4 a4, b4;
#pragma unroll
                for (int i = 0; i < 4; ++i) { const float r = fsigmoid(aR[i] + ba4[i]), ig = fsigmoid(aI[i] + bx4[i]); const float a = __expf(sp4[i] * r);
                    const float mult = sqrtf(fmaxf(1.0f - a * a, 0.f)); a4[i] = a; b4[i] = mult * ig * ucv[i]; }
                *(f32x4*)(A2 + fr * 68 + j0) = a4; *(f32x4*)(B2 + fr * 68 + j0) = b4; }
            wave_lds_sync();
#pragma unroll
            for (int i = 0; i < 16; ++i) { const int t = 16 * q4 + i; const int row = R0 + t;
                if (smp && (i & 7) == 0) h = p.state_lru[(size_t)(sbase + (t >> 3)) * 512 + ch];
                const float a = A2[i * 68 + lane], bb = B2[i * 68 + lane]; h = a * h + bb; Pc *= a;
                p.HSL[(size_t)row * 512 + ch] = f2bf(h); p.PP[(size_t)row * 512 + ch] = smp ? (bf16_t)0 : f2bf(Pc);
                if (smp && (i & 7) == 7) p.o_slru[(size_t)(sbase + (t >> 3)) * 512 + ch] = h; }
            wave_lds_sync();
        }
        if (!smp) { p.SUMH[(size_t)(b * 32 + c) * 512 + ch] = h; p.SUMP[(size_t)(b * 32 + c) * 512 + ch] = Pc; }
    }
}
__device__ __forceinline__ float gelu_tanh(float x) { const float z = 1.5957691216f * (x + 0.044715f * x * x * x); return x * fsigmoid(z); }
__device__ __forceinline__ void mixer2(const MixP& p, unsigned char* lds, int wid, int lane) {
    const int tid = wid * 64 + lane, fr = lane & 15, fq = lane >> 4;
    bf16_t* DL = (bf16_t*)lds;
    const int G_ = gridDim.x, cu_ = blockIdx.x; const bool remap = (G_ == 256);
    const int nmine = remap ? (((cu_ & 31) < 8) ? 2 : 1) : ((320 - cu_ + G_ - 1) / G_);
    for (int ui = 0; ui < nmine; ++ui) {
        const int unit = remap ? (ui == 0 ? cu_ : 256 + (cu_ >> 5) * 8 + (cu_ & 31)) : cu_ + ui * G_;
        const bool smp = unit >= 256; const int b = unit >> 5, c = unit & 31; const int sbase = (unit - 256) * 2;
        const int R0 = smp ? MP + (unit - 256) * 16 : b * 2048 + c * 64;
        { float carry[8];
#pragma unroll
          for (int k = 0; k < 8; ++k) carry[k] = 0.f;
          if (!smp) {
              for (int c0 = 0; c0 < c; c0 += 8) { f32x4 hh[8][2], pp[8][2];
#pragma unroll
                  for (int j = 0; j < 8; ++j) { const int cc = (c0 + j < c) ? c0 + j : c - 1; const float* sh = p.SUMH + (size_t)(b * 32 + cc) * 512 + 8 * lane; const float* sp = p.SUMP + (size_t)(b * 32 + cc) * 512 + 8 * lane;
                      hh[j][0] = *(const f32x4*)sh; hh[j][1] = *(const f32x4*)(sh + 4); pp[j][0] = *(const f32x4*)sp; pp[j][1] = *(const f32x4*)(sp + 4); }
#pragma unroll
                  for (int j = 0; j < 8; ++j) { if (c0 + j < c) {
#pragma unroll
                      for (int k = 0; k < 4; ++k) { carry[k] = hh[j][0][k] + pp[j][0][k] * carry[k]; carry[4 + k] = hh[j][1][k] + pp[j][1][k] * carry[4 + k]; } } } }
              if (c == 31 && wid == 0) { const float* sh = p.SUMH + (size_t)(b * 32 + 31) * 512 + 8 * lane; const float* sp = p.SUMP + (size_t)(b * 32 + 31) * 512 + 8 * lane;
                  const f32x4 h0 = *(const f32x4*)sh, h1 = *(const f32x4*)(sh + 4), p0 = *(const f32x4*)sp, p1 = *(const f32x4*)(sp + 4); f32x4 o0, o1;
#pragma unroll
                  for (int k = 0; k < 4; ++k) { o0[k] = h0[k] + p0[k] * carry[k]; o1[k] = h1[k] + p1[k] * carry[4 + k]; }
                  *(f32x4*)(p.o_plru + (size_t)b * 512 + 8 * lane) = o0; *(f32x4*)(p.o_plru + (size_t)b * 512 + 8 * lane + 4) = o1; } }
          const int nrr = smp ? 2 : 8;
          u32x4 hwa[8], pwa[8], gwa[8];
#pragma unroll
          for (int rr = 0; rr < 8; ++rr) { const int row = R0 + nrr * wid + (rr < nrr ? rr : nrr - 1);
              hwa[rr] = *(const u32x4*)(p.HSL + (size_t)row * 512 + 8 * lane); pwa[rr] = *(const u32x4*)(p.PP + (size_t)row * 512 + 8 * lane); gwa[rr] = *(const u32x4*)(p.PROJ + (size_t)row * NIN + 512 + 8 * lane); }
#pragma unroll
          for (int rr = 0; rr < 8; ++rr) { if (rr < nrr) { const int row = R0 + nrr * wid + rr;
              const u32x4 hw = hwa[rr], pw = pwa[rr], gw = gwa[rr];
              unsigned ow[4];
#pragma unroll
              for (int k = 0; k < 4; ++k) { const unsigned hh = hw[k], pq = pw[k], gg = gw[k];
                  const float hs0 = __uint_as_float(hh << 16) + __uint_as_float(pq << 16) * carry[2 * k], hs1 = __uint_as_float(hh & 0xffff0000u) + __uint_as_float(pq & 0xffff0000u) * carry[2 * k + 1];
                  ow[k] = cvt_pk_bf16(gelu_tanh(__uint_as_float(gg << 16)) * hs0, gelu_tanh(__uint_as_float(gg & 0xffff0000u)) * hs1); }
              u32x4 o; o.x = ow[0]; o.y = ow[1]; o.z = ow[2]; o.w = ow[3];
              *(u32x4*)(p.Y + (size_t)row * 1024 + 8 * lane) = o; } } }
        const int DLR0 = smp ? 0 : 15;
        if (smp) { const int ch = wid * 64 + lane, g = wid >> 1, win = 2 << g; const float rw = 1.0f / (float)win;
#pragma unroll 1
          for (int seg = 0; seg < 2; ++seg) { const int s = sbase + seg; float v[23];
#pragma unroll
              for (int e = 0; e < 15; ++e) v[e] = p.state_pool[((size_t)s * 15 + e) * 512 + ch];
#pragma unroll
              for (int e = 15; e < 23; ++e) v[e] = bf2f(p.PROJ[(size_t)(MP + s * 8 + e - 15) * NIN + 1024 + ch]);
#pragma unroll
              for (int t = 0; t < 8; ++t) { const float S2 = v[15 + t] + v[14 + t], S4 = S2 + (v[13 + t] + v[12 + t]), S8 = S4 + ((v[11 + t] + v[10 + t]) + (v[9 + t] + v[8 + t]));
                  const float S16 = S8 + (((v[7 + t] + v[6 + t]) + (v[5 + t] + v[4 + t])) + ((v[3 + t] + v[2 + t]) + (v[1 + t] + v[t])));
                  const float S = g == 0 ? S2 : (g == 1 ? S4 : (g == 2 ? S8 : S16));
                  DL[(seg * 8 + t) * 520 + ch] = f2bf(S * rw - v[15 + t]);
                  p.o_spool[((size_t)s * 15 + 7 + t) * 512 + ch] = v[15 + t]; }
#pragma unroll
              for (int k = 0; k < 7; ++k) p.o_spool[((size_t)s * 15 + k) * 512 + ch] = v[8 + k];
          } }
        else { const int ch = wid * 64 + lane, g = wid >> 1, win = 2 << g; const int t0 = c * 64;
          { u32x4 tv[10]; const int e0 = tid >> 6, cc = tid & 63; const bf16_t* gp = p.PROJ + ((long)(b * 2048 + t0 + e0 - 15)) * NIN + 1024 + cc * 8; bf16_t* lp = DL + e0 * 520 + cc * 8;
#pragma unroll
            for (int j = 0; j < 10; ++j) { tv[j] = (u32x4){0u, 0u, 0u, 0u}; if (e0 + 8 * j < 79 && t0 + e0 + 8 * j - 15 >= 0) tv[j] = *(const u32x4*)(gp + (long)j * 8 * NIN); }
#pragma unroll
            for (int j = 0; j < 10; ++j) if (e0 + 8 * j < 79) *(u32x4*)(lp + j * 8 * 520) = tv[j]; }
          __syncthreads();
          float S = 0.f;
          for (int j = 0; j < win; ++j) S += bf2f(DL[(78 - j) * 520 + ch]);
#pragma unroll 8
          for (int t = 63; t >= 0; --t) { const int e = 15 + t; const float ut = bf2f(DL[e * 520 + ch]); const float cnt = (float)min(t0 + t + 1, win);
              DL[e * 520 + ch] = f2bf(S * __builtin_amdgcn_rcpf(cnt) - ut);
              if (t > 0) S = S - ut + bf2f(DL[(e - win) * 520 + ch]);
              if (c == 31 && t >= 49) p.o_ppool[((size_t)b * 15 + (t - 49)) * 512 + ch] = ut; }
        }
        __syncthreads();
        { const int g = wid >> 1, jh = wid & 1;
          bf16x8 XX[4][4];
#pragma unroll
          for (int n = 0; n < 4; ++n)
#pragma unroll
              for (int kk = 0; kk < 4; ++kk) XX[n][kk] = *(const bf16x8*)(p.PwT + (size_t)g * 16384 + (64 * jh + 16 * n + fr) * 128 + 8 * fq + 32 * kk);
#pragma unroll
          for (int n = 0; n < 4; ++n) { bf16x8 X[4];
#pragma unroll
              for (int kk = 0; kk < 4; ++kk) X[kk] = XX[n][kk];
              const int j0 = g * 128 + 64 * jh + 16 * n + 4 * fq; const f32x4 sc4 = *(const f32x4*)(p.pool_scale + j0);
              const int nm = smp ? 1 : 4;
              for (int m = 0; m < nm; ++m) { f32x4 acc = {0.f, 0.f, 0.f, 0.f};
#pragma unroll
                  for (int kk = 0; kk < 4; ++kk) { const bf16x8 Yf = *(const bf16x8*)(DL + (DLR0 + 16 * m + fr) * 520 + g * 128 + 8 * fq + 32 * kk); acc = mfma16(X[kk], Yf, acc); }
                  u32x2 w; w.x = cvt_pk_bf16(acc[0] * sc4[0], acc[1] * sc4[1]); w.y = cvt_pk_bf16(acc[2] * sc4[2], acc[3] * sc4[3]);
                  *(u32x2*)(p.Y + (size_t)(R0 + 16 * m + fr) * 1024 + 512 + j0) = w; } } }
        __syncthreads();
    }
}
struct AttP { const bf16_t *Q, *KB, *VT; bf16_t* O; const float *cache_k, *cache_v; };
constexpr int ASTR = 528;
__device__ __forceinline__ void attn_prompt(const AttP& p, unsigned char* lds, int wid, int lane) {
    const int tid = wid * 64 + lane, fr = lane & 15, fq = lane >> 4;
    for (int unit = blockIdx.x; unit < 256; unit += gridDim.x) {
        const int b = unit >> 5, h = (unit >> 3) & 3, qb = unit & 7;
        const int rowbase = b * 2048 + qb * 256 + wid * 32;
        { const bf16_t* gp = p.KB + (size_t)(b * 256 + (tid >> 5)) * 1024 + h * 256 + (tid & 31) * 8; unsigned char* lp = lds + (tid >> 5) * ASTR + (tid & 31) * 16;
#pragma unroll 1
          for (int j0 = 0; j0 < 16; j0 += 4) { u32x4 tv[4];
#pragma unroll
              for (int j = 0; j < 4; ++j) tv[j] = *(const u32x4*)(gp + (size_t)(j0 + j) * 16 * 1024);
#pragma unroll
              for (int j = 0; j < 4; ++j) *(u32x4*)(lp + (j0 + j) * 16 * ASTR) = tv[j]; } }
        const bf16_t* qp = p.Q + (size_t)(rowbase + fr) * 1024 + h * 256 + 8 * fq;
        __syncthreads();
        bf16x8 Pf[8][2]; float mxc[2][2], smc[2][2];
#pragma unroll
        for (int kh = 0; kh < 2; ++kh) {
            f32x4 S[8][2];
#pragma unroll
            for (int n = 0; n < 8; ++n) { S[n][0] = (f32x4){0.f, 0.f, 0.f, 0.f}; S[n][1] = (f32x4){0.f, 0.f, 0.f, 0.f}; }
#pragma unroll
            for (int kk = 0; kk < 8; ++kk) { const bf16x8 q0 = *(const bf16x8*)(qp + 32 * kk), q1 = *(const bf16x8*)(qp + 16 * 1024 + 32 * kk);
#pragma unroll
                for (int n = 0; n < 8; ++n) { const bf16x8 kf = *(const bf16x8*)(lds + (128 * kh + 16 * n + fr) * ASTR + (32 * kk + 8 * fq) * 2); S[n][0] = mfma16(kf, q0, S[n][0]); S[n][1] = mfma16(kf, q1, S[n][1]); }
                __builtin_amdgcn_sched_barrier(0); }
#pragma unroll
            for (int m = 0; m < 2; ++m) { float mx = -3.0e38f;
#pragma unroll
                for (int n = 0; n < 8; ++n) mx = fmaxf(mx, fmaxf(fmaxf(S[n][m][0], S[n][m][1]), fmaxf(S[n][m][2], S[n][m][3])));
                mx = fmaxf(mx, __shfl_xor(mx, 16)); mx = fmaxf(mx, __shfl_xor(mx, 32));
                float sum = 0.f;
#pragma unroll
                for (int n = 0; n < 8; ++n)
#pragma unroll
                    for (int i = 0; i < 4; ++i) { const float e = __builtin_amdgcn_exp2f(S[n][m][i] - mx); S[n][m][i] = e; sum += e; }
                sum += __shfl_xor(sum, 16); sum += __shfl_xor(sum, 32); mxc[kh][m] = mx; smc[kh][m] = sum; }
#pragma unroll
            for (int k2 = 0; k2 < 4; ++k2)
#pragma unroll
                for (int m = 0; m < 2; ++m) { u32x4 w; w.x = cvt_pk_bf16(S[2 * k2][m][0], S[2 * k2][m][1]); w.y = cvt_pk_bf16(S[2 * k2][m][2], S[2 * k2][m][3]);
                    w.z = cvt_pk_bf16(S[2 * k2 + 1][m][0], S[2 * k2 + 1][m][1]); w.w = cvt_pk_bf16(S[2 * k2 + 1][m][2], S[2 * k2 + 1][m][3]); Pf[4 * kh + k2][m] = __builtin_bit_cast(bf16x8, w); }
            __builtin_amdgcn_sched_barrier(0);
        }
        float rr[2], fin[2];
#pragma unroll
        for (int m = 0; m < 2; ++m) { const float mm = fmaxf(mxc[0][m], mxc[1][m]); const float c0 = __builtin_amdgcn_exp2f(mxc[0][m] - mm), c1 = __builtin_amdgcn_exp2f(mxc[1][m] - mm);
            rr[m] = __builtin_amdgcn_exp2f(fminf(fmaxf(mxc[0][m] - mxc[1][m], -80.f), 80.f)); fin[m] = c1 / (smc[0][m] * c0 + smc[1][m] * c1); }
        __syncthreads();
        { const bf16_t* gp = p.VT + (size_t)(h * 256 + (tid >> 5)) * 2048 + b * 256 + (tid & 31) * 8; unsigned char* lp = lds + (tid >> 5) * ASTR + (tid & 31) * 16;
#pragma unroll 1
          for (int j0 = 0; j0 < 16; j0 += 4) { u32x4 tv[4];
#pragma unroll
              for (int j = 0; j < 4; ++j) tv[j] = *(const u32x4*)(gp + (size_t)(j0 + j) * 16 * 2048);
#pragma unroll
              for (int j = 0; j < 4; ++j) *(u32x4*)(lp + (j0 + j) * 16 * ASTR) = tv[j]; } }
        __syncthreads();
#pragma unroll 1
        for (int dh = 0; dh < 2; ++dh) { f32x4 O[8][2];
#pragma unroll
            for (int dn = 0; dn < 8; ++dn) { O[dn][0] = (f32x4){0.f, 0.f, 0.f, 0.f}; O[dn][1] = (f32x4){0.f, 0.f, 0.f, 0.f};
                const unsigned char* vrow = lds + (dh * 128 + dn * 16 + fr) * ASTR;
#pragma unroll
                for (int k2 = 0; k2 < 8; ++k2) { const u32x2 lo = *(const u32x2*)(vrow + (32 * k2 + 4 * fq) * 2), hi = *(const u32x2*)(vrow + (32 * k2 + 16 + 4 * fq) * 2);
                    u32x4 w; w.x = lo.x; w.y = lo.y; w.z = hi.x; w.w = hi.y; const bf16x8 vf = __builtin_bit_cast(bf16x8, w);
                    if (k2 == 4) { O[dn][0] = O[dn][0] * rr[0]; O[dn][1] = O[dn][1] * rr[1]; }
                    O[dn][0] = mfma16(vf, Pf[k2][0], O[dn][0]); O[dn][1] = mfma16(vf, Pf[k2][1], O[dn][1]); }
                __builtin_amdgcn_sched_barrier(0); }
#pragma unroll
            for (int dn = 0; dn < 8; ++dn)
#pragma unroll
                for (int m = 0; m < 2; ++m) { const f32x4 o = O[dn][m] * fin[m]; u32x2 w; w.x = cvt_pk_bf16(o[0], o[1]); w.y = cvt_pk_bf16(o[2], o[3]);
                    *(u32x2*)(p.O + (size_t)(rowbase + 16 * m + fr) * 1024 + h * 256 + dh * 128 + dn * 16 + 4 * fq) = w; } }
        __syncthreads();
    }
}
__device__ __forceinline__ void attn_sample(const AttP& p, unsigned char* lds, int wid, int lane) {
    const int tid = wid * 64 + lane, fr = lane & 15, fq = lane >> 4;
    float* SS = (float*)lds;
    float* PT = (float*)(lds + 8320);
    float* OP = (float*)(lds + 16640);
    for (int unit = blockIdx.x; unit < 512; unit += gridDim.x) {
        const int s = unit >> 2, h = unit & 3;
        bf16x8 Qf[8];
#pragma unroll
        for (int kk = 0; kk < 8; ++kk) { u32x4 w = {0u, 0u, 0u, 0u}; if (fr < 8) w = *(const u32x4*)(p.Q + (size_t)(MP + 8 * s + fr) * 1024 + h * 256 + 32 * kk + 8 * fq); Qf[kk] = __builtin_bit_cast(bf16x8, w); }
#pragma unroll
        for (int n = 0; n < 2; ++n) { const int key = 32 * wid + 16 * n + fr; const float* kp = p.cache_k + (((size_t)(s * 256 + key)) * 4 + h) * 256 + 8 * fq;
            f32x4 acc = {0.f, 0.f, 0.f, 0.f};
#pragma unroll
            for (int kk = 0; kk < 8; ++kk) { const f32x4 a0 = *(const f32x4*)(kp + 32 * kk), a1 = *(const f32x4*)(kp + 32 * kk + 4);
                u32x4 w; w.x = cvt_pk_bf16(a0[0], a0[1]); w.y = cvt_pk_bf16(a0[2], a0[3]); w.z = cvt_pk_bf16(a1[0], a1[1]); w.w = cvt_pk_bf16(a1[2], a1[3]);
                acc = mfma16(__builtin_bit_cast(bf16x8, w), Qf[kk], acc); }
            if (fr < 8) *(f32x4*)(SS + fr * 260 + 32 * wid + 16 * n + 4 * fq) = acc; }
        __syncthreads();
        { const f32x4 v = *(const f32x4*)(SS + wid * 260 + 4 * lane);
          const float mx = wave_max(fmaxf(fmaxf(v[0], v[1]), fmaxf(v[2], v[3])));
          f32x4 e; float sum = 0.f;
#pragma unroll
          for (int i = 0; i < 4; ++i) { e[i] = __builtin_amdgcn_exp2f(v[i] - mx); sum += e[i]; }
          sum = wave_sum(sum); const float is = 1.0f / sum;
#pragma unroll
          for (int i = 0; i < 4; ++i) PT[(4 * lane + i) * 8 + wid] = e[i] * is; }
        __syncthreads();
        { float o[8][4];
#pragma unroll
          for (int q = 0; q < 8; ++q)
#pragma unroll
              for (int i = 0; i < 4; ++i) o[q][i] = 0.f;
          const float* vp = p.cache_v + (((size_t)(s * 256 + 32 * wid)) * 4 + h) * 256 + 4 * lane;
#pragma unroll 8
          for (int kq = 0; kq < 32; ++kq) { const f32x4 v = *(const f32x4*)(vp + (size_t)kq * 1024); const f32x4 pa = *(const f32x4*)(PT + (32 * wid + kq) * 8), pb = *(const f32x4*)(PT + (32 * wid + kq) * 8 + 4);
#pragma unroll
              for (int q = 0; q < 4; ++q)
#pragma unroll
                  for (int i = 0; i < 4; ++i) { o[q][i] += pa[q] * v[i]; o[4 + q][i] += pb[q] * v[i]; } }
#pragma unroll
          for (int q = 0; q < 8; ++q) *(f32x4*)(OP + (size_t)(wid * 8 + q) * 256 + 4 * lane) = (f32x4){o[q][0], o[q][1], o[q][2], o[q][3]}; }
        __syncthreads();
        { const int q = tid >> 6, d4 = (tid & 63) * 4; f32x4 a = {0.f, 0.f, 0.f, 0.f};
#pragma unroll
          for (int w = 0; w < 8; ++w) a += *(const f32x4*)(OP + (size_t)(w * 8 + q) * 256 + d4);
          u32x2 ww; ww.x = cvt_pk_bf16(a[0], a[1]); ww.y = cvt_pk_bf16(a[2], a[3]);
          *(u32x2*)(p.O + (size_t)(MP + 8 * s + q) * 1024 + h * 256 + d4) = ww; }
        __syncthreads();
    }
}
struct SmallEpi { int mode; const bf16_t* xin; float* xout; bf16_t* xb; float* ss; float alpha; bf16_t* O; const float* ssin; float mul; };
__device__ __forceinline__ void small_gemm(unsigned char* lds, const bf16_t* A, const bf16_t* Bt, int K, const SmallEpi& E, int wid, int lane) {
    const int tid = wid * 64 + lane, fr = lane & 15, fq = lane >> 4;
    float* RED = (float*)lds;
    for (int t = blockIdx.x; t < 256; t += gridDim.x) {
        const int r0 = (t >> 4) * 64, c0 = (t & 15) * 64; const int np = K >> 6, base = np >> 3, rem = np & 7; const int cnt = base + (wid < rem ? 1 : 0), start = wid * base + (wid < rem ? wid : rem);
        const bf16_t* ap = A + (size_t)(r0 + fr) * K + start * 64 + 8 * fq; const bf16_t* bp = Bt + (size_t)(c0 + fr) * K + start * 64 + 8 * fq;
        f32x4 acc[4][4];
#pragma unroll
        for (int m = 0; m < 4; ++m)
#pragma unroll
            for (int n = 0; n < 4; ++n) acc[m][n] = (f32x4){0.f, 0.f, 0.f, 0.f};
        bf16x8 a[2][4], b[2][4];
#pragma unroll
        for (int hh = 0; hh < 2; ++hh)
#pragma unroll
            for (int m = 0; m < 4; ++m) { a[hh][m] = *(const bf16x8*)(ap + (size_t)16 * m * K + 32 * hh); b[hh][m] = *(const bf16x8*)(bp + (size_t)16 * m * K + 32 * hh); }
        for (int st = 0; st < cnt; ++st) { bf16x8 an[2][4], bn[2][4];
            const int nx = (st + 1 < cnt) ? st + 1 : st;
#pragma unroll
            for (int hh = 0; hh < 2; ++hh)
#pragma unroll
                for (int m = 0; m < 4; ++m) { an[hh][m] = *(const bf16x8*)(ap + (size_t)16 * m * K + 64 * nx + 32 * hh); bn[hh][m] = *(const bf16x8*)(bp + (size_t)16 * m * K + 64 * nx + 32 * hh); }
#pragma unroll
            for (int hh = 0; hh < 2; ++hh)
#pragma unroll
                for (int m = 0; m < 4; ++m)
#pragma unroll
                    for (int n = 0; n < 4; ++n) acc[m][n] = mfma16(b[hh][n], a[hh][m], acc[m][n]);
#pragma unroll
            for (int hh = 0; hh < 2; ++hh)
#pragma unroll
                for (int m = 0; m < 4; ++m) { a[hh][m] = an[hh][m]; b[hh][m] = bn[hh][m]; } }
#pragma unroll
        for (int m = 0; m < 4; ++m)
#pragma unroll
            for (int n = 0; n < 4; ++n) { const int row = 16 * m + fr; *(f32x4*)(RED + (size_t)(wid * 64 + row) * 64 + ((16 * n + 4 * fq + 4 * row) & 63)) = acc[m][n]; }
        __syncthreads();
        { const int rr = tid >> 3, cc = (tid & 7) * 8; f32x4 v0 = {0.f, 0.f, 0.f, 0.f}, v1 = {0.f, 0.f, 0.f, 0.f};
#pragma unroll
          for (int w = 0; w < 8; ++w) { v0 += *(const f32x4*)(RED + (size_t)(w * 64 + rr) * 64 + ((cc + 4 * rr) & 63)); v1 += *(const f32x4*)(RED + (size_t)(w * 64 + rr) * 64 + ((cc + 4 + 4 * rr) & 63)); }
          const int row = r0 + rr, col = c0 + cc;
          if (E.mode == 0) { const u32x4 xw = *(const u32x4*)(E.xin + (size_t)row * 1024 + col);
              const f32x4 a0 = {__uint_as_float(xw.x << 16), __uint_as_float(xw.x & 0xffff0000u), __uint_as_float(xw.y << 16), __uint_as_float(xw.y & 0xffff0000u)};
              const f32x4 a1 = {__uint_as_float(xw.z << 16), __uint_as_float(xw.z & 0xffff0000u), __uint_as_float(xw.w << 16), __uint_as_float(xw.w & 0xffff0000u)};
              v0 = a0 + v0 * E.alpha; v1 = a1 + v1 * E.alpha;
              if (E.xout) { *(f32x4*)(E.xout + (size_t)row * 1024 + col) = v0; *(f32x4*)(E.xout + (size_t)row * 1024 + col + 4) = v1; }
              if (E.xb) { u32x4 w; w.x = cvt_pk_bf16(v0[0], v0[1]); w.y = cvt_pk_bf16(v0[2], v0[3]); w.z = cvt_pk_bf16(v1[0], v1[1]); w.w = cvt_pk_bf16(v1[2], v1[3]); *(u32x4*)(E.xb + (size_t)row * 1024 + col) = w; }
              float sq = (v0[0] * v0[0] + v0[1] * v0[1]) + (v0[2] * v0[2] + v0[3] * v0[3]) + (v1[0] * v1[0] + v1[1] * v1[1]) + (v1[2] * v1[2] + v1[3] * v1[3]);
              sq += __shfl_xor(sq, 1); sq += __shfl_xor(sq, 2); sq += __shfl_xor(sq, 4);
              if ((tid & 7) == 0) unsafeAtomicAdd(E.ss + row, sq); }
          else { const float rs = pg8::rstd_of(E.ssin[row]) * E.mul; v0 = v0 * rs; v1 = v1 * rs;
              u32x4 w; w.x = cvt_pk_bf16(v0[0], v0[1]); w.y = cvt_pk_bf16(v0[2], v0[3]); w.z = cvt_pk_bf16(v1[0], v1[1]); w.w = cvt_pk_bf16(v1[2], v1[3]); *(u32x4*)(E.O + (size_t)row * 1024 + col) = w; } }
        __syncthreads();
    }
}
#ifndef PHMASK
#define PHMASK 0xffff
#endif
#define SS1 ((float*)(ws + WS_SS))
#define SS2 (SS1 + MT)
#define SS3 (SS1 + 2 * MT)
#define SS4 (SS1 + 3 * MT)
#define SS0 ((float*)(ws + WS_SS0))
#define SSM ((float*)(ws + WS_SSM))
#define W1GU ((bf16_t*)(ws + WS_W1GU))
#define W1D ((bf16_t*)(ws + WS_W1D))
#define W2GU ((bf16_t*)(ws + WS_W2GU))
#define W2D ((bf16_t*)(ws + WS_W2D))
#define WIN ((bf16_t*)(ws + WS_WIN))
#define WOUT ((bf16_t*)(ws + WS_WOUT))
#define WQ ((bf16_t*)(ws + WS_WQ))
#define WKV ((bf16_t*)(ws + WS_WKV))
#define WO ((bf16_t*)(ws + WS_WO))
#define WAT ((bf16_t*)(ws + WS_WAT))
#define WXT ((bf16_t*)(ws + WS_WXT))
#define PWT ((bf16_t*)(ws + WS_PWT))
#define XB ((bf16_t*)(ws + WS_XB))
#define X ((float*)(ws + WS_X))
#define H ((bf16_t*)(ws + WS_H))
#define PROJ ((bf16_t*)(ws + WS_PROJ))
#define MEMB ((bf16_t*)(ws + WS_MEMB))
#define KB ((bf16_t*)(ws + WS_KB))
#define VT ((bf16_t*)(ws + WS_VT))
#define Yb ((bf16_t*)(ws + WS_Y))
#define Qb ((bf16_t*)(ws + WS_Q))
#define Ob ((bf16_t*)(ws + WS_O))
#define HSL ((bf16_t*)(ws + WS_HSL))
#define PPb ((bf16_t*)(ws + WS_PP))
#define SUMH ((float*)(ws + WS_SUMH))
#define SUMP ((float*)(ws + WS_SUMP))

typedef const __attribute__((address_space(4))) Args CArgs0;
__global__ void __launch_bounds__(NTHR, 2) fwd_megakernel(Args args) {
    __shared__ __attribute__((aligned(16))) unsigned char lds_raw[136 * 1024];
    cg::grid_group grid = cg::this_grid();
    { volatile LAS unsigned* st0 = (volatile LAS unsigned*)((LAS unsigned char*)lds_raw + 139248); if (threadIdx.x < 4) st0[threadIdx.x] = 0u; }
    __syncthreads();
    unsigned char* A0_ws = ((CArgs0*)__builtin_amdgcn_kernarg_segment_ptr())->ws;
    XcdBarrier xbar = xcd_barrier_post((unsigned*)(A0_ws + WS_BAR), (volatile LAS unsigned*)((LAS unsigned char*)lds_raw + 139248));
    PG8_LAS unsigned char* ldsL = (PG8_LAS unsigned char*)lds_raw;
    unsigned char* lds = lds_raw;
    const int G = gridDim.x, cu = blockIdx.x; (void)args;
    typedef const __attribute__((address_space(4))) Args CArgs;
    CArgs* ap0 = (CArgs*)__builtin_amdgcn_kernarg_segment_ptr();
#define PHASE_ARGS CArgs* A_ = ap0; asm volatile("" : "+s"(A_)); const float* const __attribute__((address_space(4)))* in = A_->in; unsigned char* ws = A_->ws; float* out = A_->out; (void)in; (void)ws; (void)out; int tid_ = threadIdx.x; asm volatile("" : "+v"(tid_)); const int tid = tid_, lane = tid_ & 63, wid = __builtin_amdgcn_readfirstlane(tid_ >> 6); (void)tid; (void)lane; (void)wid;

#if (PHMASK >> 0) & 1
    { PHASE_ARGS
    {
        float* scr = (float*)(lds + wid * 16640);
        const int gw = cu * NWAVES + wid, NGW = G * NWAVES;
        constexpr int I_GU = 16 * 44, I_D = 44 * 16, I_IN = 16 * 24, I_SQ = 16 * 16, I_HD = 1, I_PG = 4;
        constexpr int NITEMS = 2 * (2 * I_GU + I_D) + I_IN + 5 * I_SQ + 2 * 8 * I_HD + 4 * I_PG;
        for (int it = gw; it < NITEMS; it += NGW) {
            int r = it;
            if (r < I_GU) { tr_item(in[9], DM, FF, in[8], W1GU, 128, 256, 0, scr, r, lane); continue; } r -= I_GU;
            if (r < I_GU) { tr_item(in[10], DM, FF, in[8], W1GU, 128, 256, 128, scr, r, lane); continue; } r -= I_GU;
            if (r < I_D) { tr_item(in[11], FF, DM, nullptr, W1D, DM, 0, 0, scr, r, lane); continue; } r -= I_D;
            if (r < I_GU) { tr_item(in[31], DM, FF, in[30], W2GU, 128, 256, 0, scr, r, lane); continue; } r -= I_GU;
            if (r < I_GU) { tr_item(in[32], DM, FF, in[30], W2GU, 128, 256, 128, scr, r, lane); continue; } r -= I_GU;
            if (r < I_D) { tr_item(in[33], FF, DM, nullptr, W2D, DM, 0, 0, scr, r, lane); continue; } r -= I_D;
            if (r < I_IN) { tr_item(in[13], DM, NIN, in[12], WIN, NIN, 0, 0, scr, r, lane); continue; } r -= I_IN;
            if (r < I_SQ) { tr_item(in[23], DM, DM, nullptr, WOUT, DM, 0, 0, scr, r, lane); continue; } r -= I_SQ;
            if (r < I_SQ) { tr_item(in[26], DM, DM, in[24], WQ, DM, 0, 0, scr, r, lane); continue; } r -= I_SQ;
            if (r < I_SQ) { tr_item(in[27], DM, DM, in[25], WKV, DM, 0, 0, scr, r, lane); continue; } r -= I_SQ;
            if (r < I_SQ) { tr_item(in[28], DM, DM, in[25], WKV, DM, 0, 1024, scr, r, lane); continue; } r -= I_SQ;
            if (r < I_SQ) { tr_item(in[29], DM, DM, nullptr, WO, DM, 0, 0, scr, r, lane); continue; } r -= I_SQ;
            if (r < 8 * I_HD) { const int g = r / I_HD; tr_item(in[16] + g * 4096, 64, 64, nullptr, WAT + g * 4096, 64, 0, 0, scr, r % I_HD, lane); continue; } r -= 8 * I_HD;
            if (r < 8 * I_HD) { const int g = r / I_HD; tr_item(in[18] + g * 4096, 64, 64, nullptr, WXT + g * 4096, 64, 0, 0, scr, r % I_HD, lane); continue; } r -= 8 * I_HD;
            { const int g = r / I_PG; tr_item(in[21] + g * 16384, 128, 128, nullptr, PWT + g * 16384, 128, 0, 0, scr, r % I_PG, lane); }
        }
        for (int m2 = gw; m2 < (MT + 2048) / 2; m2 += NGW) {
            const int m = 2 * m2; const float* src; bf16_t* dst; float* sso;
            if (m < MP) { src = in[0] + (size_t)m * DM; dst = XB + (size_t)m * DM; sso = SS0 + m; }
            else if (m < MT) { src = in[1] + (size_t)(m - MP) * DM; dst = XB + (size_t)m * DM; sso = SS0 + m; }
            else { src = in[2] + (size_t)(m - MT) * DM; dst = MEMB + (size_t)(m - MT) * DM; sso = SSM + (m - MT); }
            const f32x4* xr = (const f32x4*)src + lane; f32x4 v[8]; float s0 = 0.f, s1 = 0.f;
#pragma unroll
            for (int j = 0; j < 8; ++j) v[j] = xr[64 * j];
#pragma unroll
            for (int j = 0; j < 4; ++j) { s0 += (v[j][0] * v[j][0] + v[j][1] * v[j][1]) + (v[j][2] * v[j][2] + v[j][3] * v[j][3]); s1 += (v[4 + j][0] * v[4 + j][0] + v[4 + j][1] * v[4 + j][1]) + (v[4 + j][2] * v[4 + j][2] + v[4 + j][3] * v[4 + j][3]); }
            s0 = wave_sum(s0); s1 = wave_sum(s1);
            u32x2* o8 = (u32x2*)dst + lane;
#pragma unroll
            for (int j = 0; j < 8; ++j) { u32x2 w; w.x = cvt_pk_bf16(v[j][0], v[j][1]); w.y = cvt_pk_bf16(v[j][2], v[j][3]); o8[64 * j] = w; }
            if (lane == 0) { sso[0] = s0; sso[1] = s1; }
        }
    }
    }
#endif
    if (__builtin_expect(A0_ws == nullptr, 0)) grid.sync();
    xcd_barrier(xbar);
#if (PHMASK >> 1) & 1
    { PHASE_ARGS
    { pg8::Gemm g{XB, W1GU, MT, NGU, DM}; pg8::StaticOrder S; S.init(MT, NGU, G, cu); pg8::EpiSwiGLU E{H, SS0, FF};
      pg8::gemm_phase<pg8::EpiSwiGLU, pg8::StaticOrder, true, true>(ldsL, g, S, E); }
    }
#endif
    xcd_barrier(xbar);
#if (PHMASK >> 2) & 1
    { PHASE_ARGS
    { pg8::Gemm g{H, W1D, MP, DM, FF}; pg8::StaticOrder S; S.init(MP, DM, G, cu); pg8::EpiResid E{XB, nullptr, XB, SS1, 0.5f};
      pg8::gemm_phase<pg8::EpiResid, pg8::StaticOrder, true, true>(ldsL, g, S, E);
      SmallEpi se{0, XB + (size_t)MP * DM, nullptr, XB + (size_t)MP * DM, SS1 + MP, 0.5f, nullptr, nullptr, 0.f};
      small_gemm(lds, H + (size_t)MP * FF, W1D, FF, se, wid, lane); }
    }
#endif
    xcd_barrier(xbar);
#if (PHMASK >> 3) & 1
    { PHASE_ARGS
    { pg8::Gemm g{XB, WIN, MT, NIN, DM}; pg8::StaticOrder S; S.init(MT, NIN, G, cu); pg8::EpiScaleBf16 E{PROJ, NIN, SS1, 1.0f};
      pg8::gemm_phase<pg8::EpiScaleBf16, pg8::StaticOrder, true, true>(ldsL, g, S, E); }
    { pg8::Gemm g{MEMB, WKV, 2048, 2048, DM}; pg8::StaticOrder S; S.init(2048, 2048, G, (cu + G - 152) % G); pg8::EpiKV E{out + OUT_PMK, out + OUT_PMV, KB, SSM};
      pg8::gemm_phase<pg8::EpiKV, pg8::StaticOrder, true, true>(ldsL, g, S, E); }
    { pg8::Gemm g{WKV + (size_t)1024 * DM, MEMB, 1024, 2048, DM}; pg8::StaticOrder S; S.init(1024, 2048, G, (cu + G - 216) % G); pg8::EpiVT E{VT, SSM};
      pg8::gemm_phase<pg8::EpiVT, pg8::StaticOrder, true, true>(ldsL, g, S, E); }
    }
#endif
    xcd_barrier(xbar);
#define MIXP_INIT {PROJ, in[14], in[15], in[17], in[19], in[20], in[3], in[4], in[5], in[22], WAT, WXT, PWT, HSL, PPb, Yb, SUMH, SUMP, \
            out + OUT_PCONV, out + OUT_PLRU, out + OUT_PPOOL, out + OUT_SCONV, out + OUT_SLRU, out + OUT_SPOOL}
#if (PHMASK >> 4) & 1
    { PHASE_ARGS
    { MixP mp MIXP_INIT; mixer1(mp, lds, wid, lane); }
    }
#endif
    xcd_barrier(xbar);
#if (PHMASK >> 5) & 1
    { PHASE_ARGS
    { MixP mp MIXP_INIT; mixer2(mp, lds, wid, lane); }
    }
#endif
    xcd_barrier(xbar);
#if (PHMASK >> 6) & 1
    { PHASE_ARGS
    { pg8::Gemm g{Yb, WOUT, MP, DM, DM}; pg8::StaticOrder S; S.init(MP, DM, G, cu); pg8::EpiResid E{XB, nullptr, XB, SS2, 1.0f};
      pg8::gemm_phase<pg8::EpiResid, pg8::StaticOrder, true, true>(ldsL, g, S, E);
      SmallEpi se{0, XB + (size_t)MP * DM, nullptr, XB + (size_t)MP * DM, SS2 + MP, 1.0f, nullptr, nullptr, 0.f};
      small_gemm(lds, Yb + (size_t)MP * DM, WOUT, DM, se, wid, lane); }
    }
#endif
    xcd_barrier(xbar);
#if (PHMASK >> 7) & 1
    { PHASE_ARGS
    { pg8::Gemm g{XB, WQ, MP, DM, DM}; pg8::StaticOrder S; S.init(MP, DM, G, cu); pg8::EpiScaleBf16 E{Qb, DM, SS2, 0.0625f * 1.4426950408889634f};
      pg8::gemm_phase<pg8::EpiScaleBf16, pg8::StaticOrder, true, true>(ldsL, g, S, E);
      SmallEpi se{1, nullptr, nullptr, nullptr, nullptr, 0.f, Qb + (size_t)MP * DM, SS2 + MP, 0.0625f * 1.4426950408889634f};
      small_gemm(lds, XB + (size_t)MP * DM, WQ, DM, se, wid, lane); }
    }
#endif
    xcd_barrier(xbar);
#if (PHMASK >> 8) & 1
    { PHASE_ARGS
    { AttP ap{Qb, KB, VT, Ob, in[6], in[7]};
#pragma unroll 1
      for (int st = 0; st < 2; ++st) {
#ifndef NO_ATT_P
        if ((st ^ (cu & 1)) == 0) attn_prompt(ap, lds, wid, lane);
#endif
#ifndef NO_ATT_S
        if ((st ^ (cu & 1)) != 0) attn_sample(ap, lds, wid, lane);
#endif
      } }
    }
#endif
    xcd_barrier(xbar);
#if (PHMASK >> 9) & 1
    { PHASE_ARGS
    { pg8::Gemm g{Ob, WO, MP, DM, DM}; pg8::StaticOrder S; S.init(MP, DM, G, cu); pg8::EpiResid E{XB, nullptr, XB, SS3, 1.0f};
      pg8::gemm_phase<pg8::EpiResid, pg8::StaticOrder, true, true>(ldsL, g, S, E);
      SmallEpi se{0, XB + (size_t)MP * DM, nullptr, XB + (size_t)MP * DM, SS3 + MP, 1.0f, nullptr, nullptr, 0.f};
      small_gemm(lds, Ob + (size_t)MP * DM, WO, DM, se, wid, lane); }
    }
#endif
    xcd_barrier(xbar);
#if (PHMASK >> 10) & 1
    { PHASE_ARGS
    { pg8::Gemm g{XB, W2GU, MT, NGU, DM}; pg8::StaticOrder S; S.init(MT, NGU, G, cu); pg8::EpiSwiGLU E{H, SS3, FF};
      pg8::gemm_phase<pg8::EpiSwiGLU, pg8::StaticOrder, true, true>(ldsL, g, S, E); }
    }
#endif
    xcd_barrier(xbar);
#if (PHMASK >> 11) & 1
    { PHASE_ARGS
    { pg8::Gemm g{H, W2D, MP, DM, FF}; pg8::StaticOrder S; S.init(MP, DM, G, cu); pg8::EpiResid E{XB, nullptr, XB, SS4, 0.5f};
      pg8::gemm_phase<pg8::EpiResid, pg8::StaticOrder, true, true>(ldsL, g, S, E);
      SmallEpi se{0, XB + (size_t)MP * DM, nullptr, XB + (size_t)MP * DM, SS4 + MP, 0.5f, nullptr, nullptr, 0.f};
      small_gemm(lds, H + (size_t)MP * FF, W2D, FF, se, wid, lane); }
    }
#endif
    xcd_barrier(xbar);
#if (PHMASK >> 12) & 1
    { PHASE_ARGS
    { const int gw = cu * NWAVES + wid, NGW = G * NWAVES; const f32x4* gn = (const f32x4*)in[34];
      f32x4 g0[2], g1[2];
#pragma unroll
      for (int j = 0; j < 2; ++j) { g0[j] = gn[2 * lane + 128 * j]; g1[j] = gn[2 * lane + 128 * j + 1]; }
      for (int m4 = gw; m4 < MT / 4; m4 += NGW) { u32x4 xw[4][2]; float rs[4];
#pragma unroll
          for (int r = 0; r < 4; ++r) { const int m = 4 * m4 + r; rs[r] = pg8::rstd_of(SS4[m]); const u32x4* xr = (const u32x4*)(XB + (size_t)m * DM) + lane; xw[r][0] = xr[0]; xw[r][1] = xr[64]; }
#pragma unroll
          for (int r = 0; r < 4; ++r) { f32x4* orow = (f32x4*)(out + OUT_Y + (size_t)(4 * m4 + r) * DM);
#pragma unroll
              for (int j = 0; j < 2; ++j) { const u32x4 w = xw[r][j];
                  const f32x4 a0 = {__uint_as_float(w.x << 16), __uint_as_float(w.x & 0xffff0000u), __uint_as_float(w.y << 16), __uint_as_float(w.y & 0xffff0000u)};
                  const f32x4 a1 = {__uint_as_float(w.z << 16), __uint_as_float(w.z & 0xffff0000u), __uint_as_float(w.w << 16), __uint_as_float(w.w & 0xffff0000u)};
                  orow[2 * lane + 128 * j] = a0 * rs[r] * g0[j]; orow[2 * lane + 128 * j + 1] = a1 * rs[r] * g1[j]; } } } }
    }
#endif
}

extern "C" void kernel_launch(void* const* d_in, const int* in_sizes, int n_in, void* d_out, int out_size, void* d_ws, size_t ws_size, hipStream_t stream) {
    static int grid = 0;
    if (grid == 0) {
        if (n_in != 35 || (size_t)out_size != OUT_TOTAL || ws_size < WS_END) { fprintf(stderr, "kernel_launch: unexpected shapes: n_in %d out %d ws %zu (need %zu)\n", n_in, out_size, ws_size, (size_t)WS_END); grid = -1; return; }
        int dev = 0, cus = 0, per = 0;
        hipGetDevice(&dev); hipDeviceGetAttribute(&cus, hipDeviceAttributeMultiprocessorCount, dev);
        hipOccupancyMaxActiveBlocksPerMultiprocessor(&per, fwd_megakernel, NTHR, 0);
        if (per < 1) { fprintf(stderr, "kernel_launch: occupancy query says %d blocks/CU\n", per); grid = -1; return; }
        grid = cus;
    }
    if (grid < 0) return;
    hipMemsetAsync((char*)d_ws + WS_BAR, 0, WS_SS + WS_SS_BYTES, stream);
    Args a{};
    for (int i = 0; i < 35; ++i) a.in[i] = (const float*)d_in[i];
    a.out = (float*)d_out; a.ws = (unsigned char*)d_ws;
    void* kargs[] = {&a};
    hipError_t e = hipLaunchCooperativeKernel((void*)fwd_megakernel, dim3(grid), dim3(NTHR), kargs, 0, stream);
    if (e != hipSuccess) fprintf(stderr, "kernel_launch: cooperative launch failed: %s (grid %d)\n", hipGetErrorString(e), grid);
}
```
